# Optimizing an MI355X kernel written in HIP

```python
import math
import jax, jax.numpy as jnp
from jax import lax
import numpy as np

D_MODEL = 1024
BATCH = 4
SEQ = 4096
DEPTH = 4

MEM_LEN = 256
EPS = 1e-6
BLOCK_Q = 128
CONV_W = 3
CONV_CH = D_MODEL // 2
DIFF_HEADS = 4
DIFF_HEAD_DIM = 64
DIFF_V_DIM = 2 * DIFF_HEAD_DIM
DIFF_QK = DIFF_HEADS * 2 * DIFF_HEAD_DIM
DIFF_WIDTH = DIFF_HEADS * DIFF_V_DIM
EVEN_IN = 3 * CONV_CH + 2 * DIFF_QK + DIFF_WIDTH
EVEN_OUT = CONV_CH + DIFF_WIDTH
SB_HEADS = 16
SB_HEAD_DIM = D_MODEL // SB_HEADS
X_HEADS = 4
X_HEAD_DIM = D_MODEL // X_HEADS
D_FF = 2816
N_EVEN = (DEPTH + 1) // 2
N_ODD = DEPTH // 2

kernel_name = "hybrid_conv_diffattn_stickbreak_trunk"


def rmsnorm(x, g):
    xf = x.astype(jnp.float32)
    y = xf * lax.rsqrt(jnp.mean(xf * xf, axis=-1, keepdims=True) + EPS)
    return (y * g.astype(jnp.float32)).astype(x.dtype)


def causal_dwconv(x, w):
    S = x.shape[1]
    xp = jnp.pad(x, ((0, 0), (CONV_W - 1, 0), (0, 0)))
    out = w[CONV_W - 1] * xp[:, CONV_W - 1:CONV_W - 1 + S]
    for k in range(CONV_W - 1):
        out = out + w[k] * xp[:, k:k + S]
    return out


def to_blocks(q):
    B, H, S, d = q.shape
    return q.reshape(B, H, S // BLOCK_Q, BLOCK_Q, d).transpose(2, 0, 1, 3, 4)


def from_blocks(o):
    NB, B, H, BQ, d = o.shape
    return o.transpose(1, 2, 0, 3, 4).reshape(B, H, NB * BQ, d)


def alibi_slopes(n_heads):
    return jnp.asarray(2.0 ** (-8.0 * np.arange(1, n_heads + 1) / n_heads), dtype=jnp.float32)


def diff_attention(q1, q2, k1, k2, v, lam):
    S = v.shape[2]
    nb = S // BLOCK_Q
    scale = DIFF_HEAD_DIM ** -0.5
    key_pos = jnp.arange(S)
    slopes = alibi_slopes(DIFF_HEADS)

    def block(args):
        i, qb1, qb2 = args
        q_pos = i * BLOCK_Q + jnp.arange(BLOCK_Q)
        dist = q_pos[:, None] - key_pos[None, :]
        causal = dist >= 0
        bias = -slopes[:, None, None] * jnp.abs(dist).astype(jnp.float32)

        def probs(qb, k):
            s = jnp.einsum('bhqd,bhkd->bhqk', qb, k).astype(jnp.float32) * scale + bias
            s = jnp.where(causal, s, -jnp.inf)
            return jax.nn.softmax(s, axis=-1)

        p = probs(qb1, k1) - lam * probs(qb2, k2)
        return jnp.einsum('bhqk,bhkd->bhqd', p.astype(v.dtype), v)

    o = lax.map(block, (jnp.arange(nb), to_blocks(q1), to_blocks(q2)))
    return from_blocks(o)


def stick_breaking_attention(q, k, v):
    S = v.shape[2]
    nb = S // BLOCK_Q
    scale = SB_HEAD_DIM ** -0.5
    key_pos = jnp.arange(S)

    def block(args):
        i, qb = args
        q_pos = i * BLOCK_Q + jnp.arange(BLOCK_Q)
        strict = key_pos[None, :] < q_pos[:, None]
        z = jnp.einsum('bhqd,bhkd->bhqk', qb, k).astype(jnp.float32) * scale
        log_beta = jax.nn.log_sigmoid(z)
        log_1m = jnp.where(strict, jax.nn.log_sigmoid(-z), 0.0)
        tail = lax.cumsum(log_1m, axis=3, reverse=True) - log_1m
        a = jnp.where(strict, jnp.exp(log_beta + tail), 0.0)
        return jnp.einsum('bhqk,bhkd->bhqd', a.astype(v.dtype), v)

    o = lax.map(block, (jnp.arange(nb), to_blocks(q)))
    return from_blocks(o)


def even_mixer(h, w_in, conv_a, q_gain, k_gain, lam_vecs, subln, w_out, lam_init):
    B, S, _ = h.shape
    proj = h @ w_in
    a_b, a_c, a_x, qd, kd, vd = jnp.split(
        proj, [CONV_CH, 2 * CONV_CH, 3 * CONV_CH, 3 * CONV_CH + DIFF_QK,
               3 * CONV_CH + 2 * DIFF_QK], axis=-1)
    y_a = a_b * causal_dwconv(a_c * a_x, conv_a)
    q = rmsnorm(qd.reshape(B, S, DIFF_HEADS, 2, DIFF_HEAD_DIM), q_gain)
    k = rmsnorm(kd.reshape(B, S, DIFF_HEADS, 2, DIFF_HEAD_DIM), k_gain)
    q = q.transpose(3, 0, 2, 1, 4)
    k = k.transpose(3, 0, 2, 1, 4)
    v = vd.reshape(B, S, DIFF_HEADS, DIFF_V_DIM).transpose(0, 2, 1, 3)
    lf = lam_vecs.astype(jnp.float32)
    lam = jnp.exp(jnp.sum(lf[0] * lf[1])) - jnp.exp(jnp.sum(lf[2] * lf[3])) + lam_init
    o = diff_attention(q[0], q[1], k[0], k[1], v, lam)
    o = rmsnorm(o, subln) * (1.0 - lam_init)
    y_b = o.transpose(0, 2, 1, 3).reshape(B, S, DIFF_WIDTH)
    return jnp.concatenate([y_a, y_b], axis=-1) @ w_out


def odd_mixer(h, w_qkv, w_out):
    B, S, _ = h.shape
    qkv = (h @ w_qkv).reshape(B, S, 3, SB_HEADS, SB_HEAD_DIM).transpose(2, 0, 3, 1, 4)
    o = stick_breaking_attention(qkv[0], qkv[1], qkv[2])
    return o.transpose(0, 2, 1, 3).reshape(B, S, D_MODEL) @ w_out


def mem_attention(h, mem_n, w_q, w_kv, q_gain, k_gain, w_o):
    B, S, _ = h.shape
    M = mem_n.shape[1]
    q = rmsnorm((h @ w_q).reshape(B, S, X_HEADS, X_HEAD_DIM), q_gain)
    kv = (mem_n @ w_kv).reshape(B, M, 2, X_HEADS, X_HEAD_DIM)
    k = rmsnorm(kv[:, :, 0], k_gain)
    v = kv[:, :, 1]
    s = jnp.einsum('bqhd,bkhd->bhqk', q, k).astype(jnp.float32) * (X_HEAD_DIM ** -0.5)
    p = jax.nn.softmax(s, axis=-1)
    o = jnp.einsum('bhqk,bkhd->bqhd', p.astype(v.dtype), v)
    return o.reshape(B, S, D_MODEL) @ w_o


def conv_ffn(h, w_up, w_conv, w_down):
    u = causal_dwconv(h @ w_up, w_conv)
    gate, val = jnp.split(u, 2, axis=-1)
    return (jax.nn.silu(gate) * val) @ w_down


def setup_inputs(seed: int = 0) -> dict:
    key = jax.random.key(seed)
    ks = jax.random.split(key, 24)
    f32 = jnp.float32

    def w(k, shape, fan_in):
        return jax.random.normal(k, shape, f32) * (fan_in ** -0.5)

    def gain(k, shape):
        return 1.0 + 0.02 * jax.random.normal(k, shape, f32)

    return {
        "x": jax.random.normal(ks[0], (BATCH, SEQ, D_MODEL), f32),
        "mem": jax.random.normal(ks[1], (BATCH, MEM_LEN, D_MODEL), f32),
        "norm_mix": gain(ks[2], (DEPTH, D_MODEL)),
        "norm_xattn": gain(ks[3], (DEPTH, D_MODEL)),
        "norm_mem": gain(ks[4], (DEPTH, D_MODEL)),
        "norm_ffn": gain(ks[5], (DEPTH, D_MODEL)),
        "even_w_in": w(ks[6], (N_EVEN, D_MODEL, EVEN_IN), D_MODEL),
        "even_conv": w(ks[7], (N_EVEN, CONV_W, CONV_CH), CONV_W),
        "even_q_gain": gain(ks[8], (N_EVEN, DIFF_HEAD_DIM)),
        "even_k_gain": gain(ks[9], (N_EVEN, DIFF_HEAD_DIM)),
        "even_lambda": 0.1 * jax.random.normal(ks[10], (N_EVEN, 4, DIFF_HEAD_DIM), f32),
        "even_subln": gain(ks[11], (N_EVEN, DIFF_V_DIM)),
        "even_w_out": w(ks[12], (N_EVEN, EVEN_OUT, D_MODEL), EVEN_OUT),
        "odd_w_qkv": w(ks[13], (N_ODD, D_MODEL, 3 * D_MODEL), D_MODEL),
        "odd_w_out": w(ks[14], (N_ODD, D_MODEL, D_MODEL), D_MODEL),
        "x_w_q": w(ks[15], (DEPTH, D_MODEL, D_MODEL), D_MODEL),
        "x_w_kv": w(ks[16], (DEPTH, D_MODEL, 2 * D_MODEL), D_MODEL),
        "x_q_gain": gain(ks[17], (DEPTH, X_HEAD_DIM)),
        "x_k_gain": gain(ks[18], (DEPTH, X_HEAD_DIM)),
        "x_w_out": w(ks[19], (DEPTH, D_MODEL, D_MODEL), D_MODEL),
        "ffn_w_up": w(ks[20], (DEPTH, D_MODEL, 2 * D_FF), D_MODEL),
        "ffn_conv": w(ks[21], (DEPTH, CONV_W, 2 * D_FF), CONV_W),
        "ffn_w_down": w(ks[22], (DEPTH, D_FF, D_MODEL), D_FF),
    }


def reference(x, mem, norm_mix, norm_xattn, norm_mem, norm_ffn,
              even_w_in, even_conv, even_q_gain, even_k_gain, even_lambda, even_subln, even_w_out,
              odd_w_qkv, odd_w_out,
              x_w_q, x_w_kv, x_q_gain, x_k_gain, x_w_out,
              ffn_w_up, ffn_conv, ffn_w_down):
    for l in range(DEPTH):
        h = rmsnorm(x, norm_mix[l])
        if l % 2 == 0:
            e = l // 2
            lam_init = 0.8 - 0.6 * math.exp(-0.3 * l)
            x = x + even_mixer(h, even_w_in[e], even_conv[e], even_q_gain[e], even_k_gain[e],
                               even_lambda[e], even_subln[e], even_w_out[e], lam_init)
        else:
            o = l // 2
            x = x + odd_mixer(h, odd_w_qkv[o], odd_w_out[o])
        x = x + mem_attention(rmsnorm(x, norm_xattn[l]), rmsnorm(mem, norm_mem[l]),
                              x_w_q[l], x_w_kv[l], x_q_gain[l], x_k_gain[l], x_w_out[l])
        x = x + conv_ffn(rmsnorm(x, norm_ffn[l]), ffn_w_up[l], ffn_conv[l], ffn_w_down[l])
    return x
```

```cpp
#include <hip/hip_runtime.h>
#include <hip/hip_cooperative_groups.h>
#include <cstdio>
#include <cstdint>
namespace cg = cooperative_groups;

typedef unsigned short bf16_t;
typedef short bf16x8 __attribute__((ext_vector_type(8)));
typedef float f32x4 __attribute__((ext_vector_type(4)));
typedef float f32x16 __attribute__((ext_vector_type(16)));
typedef unsigned u32x4 __attribute__((ext_vector_type(4)));
typedef unsigned u32x2 __attribute__((ext_vector_type(2)));

#define SEQ 4096
#define DM 1024
#define NTOK 16384
#define DFF 2816
#define LOG2E 1.4426950408889634f

#define WT_IN_OFF   0ull
#define WT_OUT_OFF  (WT_IN_OFF + 3072ull * 1024 * 2)
#define WT_XQ_OFF   (WT_OUT_OFF + 1024ull * 1024 * 2)
#define WT_XKV_OFF  (WT_XQ_OFF + 1024ull * 1024 * 2)
#define WT_XO_OFF   (WT_XKV_OFF + 2048ull * 1024 * 2)
#define WT_UP_OFF   (WT_XO_OFF + 1024ull * 1024 * 2)
#define WT_DOWN_OFF (WT_UP_OFF + 5632ull * 1024 * 2)
#define H_OFF       (WT_DOWN_OFF + 1024ull * 2816 * 2)
#define MH_OFF      (H_OFF + 16384ull * 1024 * 2)
#define KM_OFF      (MH_OFF + 4 * 1024ull * 1024 * 2)
#define VTM_OFF     (KM_OFF + 4 * 1024ull * 1024 * 2)
#define WTKV4_OFF   (VTM_OFF + 4 * 1024ull * 1024 * 2)
#define R_OFF       (WTKV4_OFF + 4 * 2048ull * 1024 * 2)
#define MiB (1024ull * 1024)
#define P_OFF       (R_OFF)
#define VT_OFF      (R_OFF + 80 * MiB)
#define Y_OFF       (R_OFF + 112 * MiB)
#define O12_OFF     (R_OFF + 144 * MiB)
#define QX_OFF      (R_OFF)
#define YX_OFF      (R_OFF + 32 * MiB)
#define U_OFF       (R_OFF)
#define G_OFF       (R_OFF + 16 * MiB)
#define US_OFF      (R_OFF)
#define BAR_OFF     (R_OFF + 176 * MiB)
#define RSS_OFF     (BAR_OFF + 16384)
#define RSS_SLOT    (16384 * 16)
#define WS_NEED     (RSS_OFF + 13ull * RSS_SLOT * 4 + 4096)

struct Params {
    const float* in[23];
    float* X;
    unsigned char* ws;
};
typedef const __attribute__((address_space(4))) Params* KP;

typedef __bf16 bf16x2_t __attribute__((ext_vector_type(2)));
typedef float f32x2 __attribute__((ext_vector_type(2)));
__device__ __forceinline__ unsigned pk_bf16(float lo, float hi) {
    f32x2 v = {lo, hi};
    bf16x2_t b = __builtin_convertvector(v, bf16x2_t);
    return __builtin_bit_cast(unsigned, b);
}
__device__ __forceinline__ float bf_lo(unsigned w) { return __uint_as_float(w << 16); }
__device__ __forceinline__ float bf_hi(unsigned w) { return __uint_as_float(w & 0xffff0000u); }
__device__ __forceinline__ float wave_sum(float v) {
#pragma unroll
    for (int o = 32; o >= 1; o >>= 1) v += __shfl_xor(v, o);
    return v;
}
__device__ __forceinline__ int get_tid() { int t = threadIdx.x & 255; asm volatile("" : "+v"(t)); return t; }
__device__ __forceinline__ int get_tid512() { int t = threadIdx.x; asm volatile("" : "+v"(t)); return t; }
__device__ __forceinline__ int vhalf() { return __builtin_amdgcn_readfirstlane((int)(threadIdx.x >> 8)); }
__device__ __forceinline__ int vbid() { return (int)blockIdx.x * 2 + vhalf(); }
__device__ __forceinline__ int nvb() { return (int)gridDim.x * 2; }
__device__ __forceinline__ float dpp_ror1(float x) { return __int_as_float(__builtin_amdgcn_update_dpp(0, __float_as_int(x), 0x121, 0xf, 0xf, false)); }
__device__ __forceinline__ float dpp_ror2(float x) { return __int_as_float(__builtin_amdgcn_update_dpp(0, __float_as_int(x), 0x122, 0xf, 0xf, false)); }
__device__ __forceinline__ float fexp2(float x) { return __builtin_amdgcn_exp2f(x); }
__device__ __forceinline__ float flog2(float x) { return __builtin_amdgcn_logf(x); }

struct GemmD {
    const bf16_t* A; const bf16_t* B; int lda, ldb, K, MT, NT;
    int mode;
    void* C; int ldc; int colblk; long cbstride;
    const float* g0; const float* g1; int nq0, nq1, nsc0, nsplit; float qscale; float* aux;
    const float* rss; int rsmode;
};

__device__ __forceinline__ float rss_rstd(const float* q) {
    const f32x4 a = *(const f32x4*)q, b = *(const f32x4*)(q + 4), c = *(const f32x4*)(q + 8), e = *(const f32x4*)(q + 12);
    const f32x4 t = (a + b) + (c + e);
    return rsqrtf(((t[0] + t[1]) + (t[2] + t[3])) * (1.0f / 1024.0f) + 1e-6f);
}
__device__ __forceinline__ void gemm_epilogue(const GemmD& d, int tm, int tn, f32x4 (&acc)[8][4], const float* rstab) {
    const int tid = get_tid512(), lane = tid & 63, wid = __builtin_amdgcn_readfirstlane(tid >> 6), wr = wid >> 2, wc = wid & 3;
    const int fr = lane & 15, fq = lane >> 4;
    const int row0 = tm * 256 + wr * 128 + fr;
    const int colw = tn * 256 + wc * 64;
    if (d.mode == 1) {
        float* X = (float*)d.C; bf16_t* XB = (bf16_t*)d.g1; float* rso = d.aux;
#pragma unroll
        for (int mi = 0; mi < 8; ++mi) {
            float ss = 0.f;
#pragma unroll
            for (int ni = 0; ni < 4; ++ni) {
                const size_t off = (size_t)(row0 + mi * 16) * 1024 + colw + ni * 16 + fq * 4;
                f32x4 v = *(f32x4*)(X + off); v += acc[mi][ni]; *(f32x4*)(X + off) = v;
                ss += v[0] * v[0] + v[1] * v[1] + v[2] * v[2] + v[3] * v[3];
                u32x2 w; w.x = pk_bf16(v[0], v[1]); w.y = pk_bf16(v[2], v[3]);
                *(u32x2*)(XB + off) = w;
            }
            ss += __shfl_xor(ss, 16); ss += __shfl_xor(ss, 32);
            if (fq == 0) rso[(size_t)(row0 + mi * 16) * 16 + tn * 4 + wc] = ss;
            if (mi & 1) __builtin_amdgcn_sched_barrier(0);
        }
        return;
    }
    const float* rs = d.rss;
    const int rsmode = d.rsmode;
#define ROWF(mi_) ((rsmode == 1) ? rstab[wr * 128 + (mi_) * 16 + fr] : 1.0f)
    if (d.mode == 4) {
        const float* cw = d.g0; float* Us = d.aux; bf16_t* G = (bf16_t*)d.C;
        const int gb = tm * 2 + wr;
#pragma unroll
        for (int nh = 0; nh < 2; ++nh) {
            const int ch = tn * 128 + wc * 32 + nh * 16 + fq * 4;
            const f32x4 wg0 = *(const f32x4*)(cw + ch), wg1 = *(const f32x4*)(cw + 5632 + ch), wg2 = *(const f32x4*)(cw + 11264 + ch);
            const f32x4 wv0 = *(const f32x4*)(cw + 2816 + ch), wv1 = *(const f32x4*)(cw + 5632 + 2816 + ch), wv2 = *(const f32x4*)(cw + 11264 + 2816 + ch);
            if (fr < 2) { const int uo = (gb * 4 + fr) * 5632 + ch; const float rf0 = ROWF(0); *(f32x4*)(Us + uo) = acc[0][nh] * rf0; *(f32x4*)(Us + uo + 2816) = acc[0][nh + 2] * rf0; }
            if (fr >= 14) { const int uo = (gb * 4 + fr - 12) * 5632 + ch; const float rf7 = ROWF(7); *(f32x4*)(Us + uo) = acc[7][nh] * rf7; *(f32x4*)(Us + uo + 2816) = acc[7][nh + 2] * rf7; }
            f32x4 pg1 = {0.f, 0.f, 0.f, 0.f}, pg2 = pg1, pv1 = pg1, pv2 = pg1;
#pragma unroll
            for (int mi = 0; mi < 8; ++mi) {
                const float rf = ROWF(mi);
                const f32x4 g0 = acc[mi][nh] * rf, v0 = acc[mi][nh + 2] * rf;
                f32x4 rg1, rg2, rv1, rv2;
#pragma unroll
                for (int e = 0; e < 4; ++e) { rg1[e] = dpp_ror1(g0[e]); rg2[e] = dpp_ror2(g0[e]); rv1[e] = dpp_ror1(v0[e]); rv2[e] = dpp_ror2(v0[e]); }
                const f32x4 g1 = (fr == 0) ? pg1 : rg1, g2 = (fr < 2) ? pg2 : rg2;
                const f32x4 v1 = (fr == 0) ? pv1 : rv1, v2 = (fr < 2) ? pv2 : rv2;
                const f32x4 cg = wg2 * g0 + wg1 * g1 + wg0 * g2;
                const f32x4 cv = wv2 * v0 + wv1 * v1 + wv0 * v2;
                f32x4 o;
#pragma unroll
                for (int e = 0; e < 4; ++e) o[e] = cg[e] * __builtin_amdgcn_rcpf(1.0f + fexp2(-LOG2E * cg[e])) * cv[e];
                u32x2 w; w.x = pk_bf16(o[0], o[1]); w.y = pk_bf16(o[2], o[3]);
                *(u32x2*)(G + ((row0 + mi * 16) * 2816 + ch)) = w;
                pg1 = rg1; pg2 = rg2; pv1 = rv1; pv2 = rv2;
            }
            __builtin_amdgcn_sched_barrier(0);
        }
        return;
    }
    {
        f32x4 colf[4];
#pragma unroll
        for (int ni = 0; ni < 4; ++ni)
#pragma unroll
            for (int e = 0; e < 4; ++e) colf[ni][e] = (rsmode == 2) ? rstab[wc * 64 + ni * 16 + fq * 4 + e] : 1.0f;
        const bool donorm = (d.mode == 2) && (colw >= d.nq0) && (colw < d.nq1);
        const bool doscale = (d.mode == 2) && (colw >= d.nsc0) && (colw < d.nsplit);
        const float* g = (colw < d.nsplit) ? d.g0 : d.g1;
        const float sc = doscale ? d.qscale : 1.0f;
        bf16_t* C = (bf16_t*)d.C;
        int cb = 0; if (d.colblk) cb = colw / d.colblk;
        bf16_t* base = C + (size_t)cb * d.cbstride + (colw - cb * d.colblk);
#pragma unroll
        for (int mi = 0; mi < 8; ++mi) {
            f32x4 v[4];
            {
                const float rf = ROWF(mi);
#pragma unroll
                for (int ni = 0; ni < 4; ++ni) v[ni] = acc[mi][ni] * colf[ni] * rf;
            }
            if (donorm) {
                float ss = 0.f;
#pragma unroll
                for (int ni = 0; ni < 4; ++ni) ss += v[ni][0] * v[ni][0] + v[ni][1] * v[ni][1] + v[ni][2] * v[ni][2] + v[ni][3] * v[ni][3];
                ss += __shfl_xor(ss, 16); ss += __shfl_xor(ss, 32);
                const float rstd = rsqrtf(ss * (1.0f / 64.0f) + 1e-6f);
#pragma unroll
                for (int ni = 0; ni < 4; ++ni) { const f32x4 gv = *(const f32x4*)(g + ni * 16 + fq * 4); v[ni] = v[ni] * gv * rstd; }
            }
#pragma unroll
            for (int ni = 0; ni < 4; ++ni) {
                const f32x4 o = v[ni] * sc;
                u32x2 w; w.x = pk_bf16(o[0], o[1]); w.y = pk_bf16(o[2], o[3]);
                *(u32x2*)(base + (size_t)(row0 + mi * 16) * d.ldc + ni * 16 + fq * 4) = w;
            }
            __builtin_amdgcn_sched_barrier(0);
        }
    }
}

__device__ __forceinline__ void tile_map(int u, int MT, int NT, int& tm, int& tn) {
    const int GH = MT < 1 ? MT : 1;
    const int per = GH * NT;
    const int grp = u / per, r = u - grp * per;
    tm = grp * GH + (r % GH); tn = r / GH;
}

#define MFMA32(a, b, c) __builtin_amdgcn_mfma_f32_32x32x16_bf16((a), (b), (c), 0, 0, 0)

__device__ __forceinline__ void k64_load(u32x4 (&r)[2], const bf16_t* g, int ld) {
    const int tid = get_tid(), row = tid >> 3, ch = tid & 7;
#pragma unroll
    for (int i = 0; i < 2; ++i) r[i] = *(const u32x4*)(g + (size_t)(row + 32 * i) * ld + ch * 8);
}
__device__ __forceinline__ void k64_store(const u32x4 (&r)[2], unsigned char* lds) {
    const int tid = get_tid(), row = tid >> 3, ch = tid & 7;
    const int ofs = row * 128 + ((ch ^ ((row >> 1) & 7)) << 4);
#pragma unroll
    for (int i = 0; i < 2; ++i) *(u32x4*)(lds + ofs + i * 4096) = r[i];
}
template <int NP>
__device__ __forceinline__ void vt_load(u32x4 (&r)[NP], const bf16_t* g, size_t ld) {
    const int tid = get_tid(), row = tid >> 3, ch = tid & 7;
#pragma unroll
    for (int i = 0; i < NP; ++i) r[i] = *(const u32x4*)(g + (size_t)(row + 32 * i) * ld + ch * 8);
}
template <int NP>
__device__ __forceinline__ void vt_store(const u32x4 (&r)[NP], unsigned char* lds) {
    const int tid = get_tid(), row = tid >> 3, ch = tid & 7;
    const int ofs = row * 128 + ((ch ^ ((row >> 1) & 7)) << 4);
    const bool sw = (row >> 4) & 1;
#pragma unroll
    for (int i = 0; i < NP; ++i) {
        u32x4 v = r[i];
        if (sw) v = (u32x4){v.z, v.w, v.x, v.y};
        *(u32x4*)(lds + ofs + i * 4096) = v;
    }
}
__device__ __forceinline__ bf16x8 vt_frag(const unsigned char* lds, int mt, int kt, int s, int lane) {
    const int r = lane & 31, h = lane >> 5;
    const int row = mt * 32 + r;
    const int sw = (r >> 1) & 7, g = h ^ ((r >> 4) & 1);
    const int c1 = kt * 4 + 2 * s;
    const u32x2 lo = *(const u32x2*)(lds + row * 128 + (((c1) ^ sw) << 4) + g * 8);
    const u32x2 hi = *(const u32x2*)(lds + row * 128 + (((c1 + 1) ^ sw) << 4) + g * 8);
    u32x4 v = (u32x4){lo.x, lo.y, hi.x, hi.y};
    return __builtin_bit_cast(bf16x8, v);
}
__device__ __forceinline__ bf16x8 pack8(const f32x16& p, int s) {
    u32x4 v;
    if (s == 0) { v.x = pk_bf16(p[0], p[1]); v.y = pk_bf16(p[2], p[3]); v.z = pk_bf16(p[4], p[5]); v.w = pk_bf16(p[6], p[7]); }
    else        { v.x = pk_bf16(p[8], p[9]); v.y = pk_bf16(p[10], p[11]); v.z = pk_bf16(p[12], p[13]); v.w = pk_bf16(p[14], p[15]); }
    return __builtin_bit_cast(bf16x8, v);
}
__device__ __forceinline__ bf16x8 k64_frag(const unsigned char* lds, int kt, int ks, int lane) {
    const int r = lane & 31, h = lane >> 5;
    const int row = kt * 32 + r;
    return *(const bf16x8*)(lds + row * 128 + (((ks * 2 + h) ^ ((r >> 1) & 7)) << 4));
}

__device__ __forceinline__ void diff_attn_unit(KP p, int b, int head, int br, int qi, int cmin, unsigned char* smem, unsigned char* xch_lds, float lam, const float* subln, float osc) {
    const int tid = get_tid(), lane = tid & 63, w = tid >> 6, r = lane & 31, h = lane >> 5;
    const bf16_t* P = (const bf16_t*)(p->ws + P_OFF);
    const bf16_t* VT = (const bf16_t*)(p->ws + VT_OFF) + ((size_t)b * 512 + head * 128) * SEQ;
    const bf16_t* Pq = P + (size_t)(b * SEQ) * 2560 + 1536 + head * 128 + br * 64;
    const bf16_t* Pk = P + (size_t)(b * SEQ) * 2560 + 2048 + head * 128 + br * 64;
    const int q0w = qi * 128 + w * 32;
    const int qpos = q0w + r;
    const float slope2 = exp2f(-2.0f * (float)(head + 1)) * LOG2E;
    bf16x8 qext, kext[2];
    {
        const unsigned hi = pk_bf16(slope2, 0.f) & 0xffffu;
        const float hif = __uint_as_float(hi << 16);
        const unsigned lo = pk_bf16(slope2 - hif, 0.f) & 0xffffu;
        u32x4 qe = {h == 0 ? (hi | (lo << 16)) : 0u, 0u, 0u, 0u};
        qext = __builtin_bit_cast(bf16x8, qe);
#pragma unroll
        for (int kt = 0; kt < 2; ++kt) {
            const float rf = (float)(kt * 32 + r);
            u32x4 ke = {h == 0 ? pk_bf16(rf, rf) : 0u, 0u, 0u, 0u};
            kext[kt] = __builtin_bit_cast(bf16x8, ke);
        }
    }
    bf16x8 qf[4];
#pragma unroll
    for (int ks = 0; ks < 4; ++ks) qf[ks] = *(const bf16x8*)(Pq + (size_t)qpos * 2560 + ks * 16 + h * 8);
    f32x16 O[4];
#pragma unroll
    for (int mt = 0; mt < 4; ++mt)
#pragma unroll
        for (int i = 0; i < 16; ++i) O[mt][i] = 0.f;
    float m = -1e30f, l = 0.f;
    unsigned char* ldsK = smem; unsigned char* ldsV = smem + 8192;
    u32x4 rk[2], rv[4];
    int c = 2 * qi + 1;
    k64_load(rk, Pk + (size_t)(c * 64) * 2560, 2560);
    vt_load<4>(rv, VT + c * 64, SEQ);
    for (; c >= cmin; --c) {
        __syncthreads();
        k64_store(rk, ldsK); vt_store<4>(rv, ldsV);
        __syncthreads();
        if (c > cmin) { k64_load(rk, Pk + (size_t)((c - 1) * 64) * 2560, 2560); vt_load<4>(rv, VT + (c - 1) * 64, SEQ); }
        const int key0 = c * 64;
        if (key0 > q0w + 31) continue;
        f32x16 S[2];
#pragma unroll
        for (int kt = 0; kt < 2; ++kt) {
#pragma unroll
            for (int i = 0; i < 16; ++i) S[kt][i] = 0.f;
#pragma unroll
            for (int ks = 0; ks < 4; ++ks) S[kt] = MFMA32(k64_frag(ldsK, kt, ks, lane), qf[ks], S[kt]);
            S[kt] = MFMA32(kext[kt], qext, S[kt]);
        }
        const float bc = slope2 * (float)(key0 - q0w);
        if (key0 + 63 > q0w) {
#pragma unroll
            for (int kt = 0; kt < 2; ++kt)
#pragma unroll
                for (int i = 0; i < 16; ++i) {
                    const int key = key0 + kt * 32 + 8 * (i >> 2) + 4 * h + (i & 3);
                    if (qpos - key < 0) S[kt][i] = -INFINITY;
                }
        }
        float mx;
        {
            float m0 = -1e30f, m1 = -1e30f, m2 = -1e30f, m3 = -1e30f;
#pragma unroll
            for (int kt = 0; kt < 2; ++kt)
#pragma unroll
                for (int i = 0; i < 16; i += 4) { m0 = fmaxf(m0, S[kt][i]); m1 = fmaxf(m1, S[kt][i + 1]); m2 = fmaxf(m2, S[kt][i + 2]); m3 = fmaxf(m3, S[kt][i + 3]); }
            mx = fmaxf(fmaxf(m0, m1), fmaxf(m2, m3));
        }
        mx = fmaxf(mx, __shfl_xor(mx, 32));
        const float mn = fmaxf(m, mx + bc);
        const float alpha = fexp2(m - mn);
        m = mn;
        const float mo = mn - bc;
        float ls;
        {
            float l0 = 0.f, l1 = 0.f, l2 = 0.f, l3 = 0.f;
#pragma unroll
            for (int kt = 0; kt < 2; ++kt)
#pragma unroll
                for (int i = 0; i < 16; i += 4) {
                    const float p0 = fexp2(S[kt][i] - mo), p1 = fexp2(S[kt][i + 1] - mo), p2 = fexp2(S[kt][i + 2] - mo), p3 = fexp2(S[kt][i + 3] - mo);
                    S[kt][i] = p0; S[kt][i + 1] = p1; S[kt][i + 2] = p2; S[kt][i + 3] = p3;
                    l0 += p0; l1 += p1; l2 += p2; l3 += p3;
                }
            ls = (l0 + l1) + (l2 + l3);
        }
        l = l * alpha + ls;
#pragma unroll
        for (int mt = 0; mt < 4; ++mt)
#pragma unroll
            for (int i = 0; i < 16; ++i) O[mt][i] *= alpha;
#pragma unroll
        for (int kt = 0; kt < 2; ++kt)
#pragma unroll
            for (int s = 0; s < 2; ++s) {
                const bf16x8 pb = pack8(S[kt], s);
#pragma unroll
                for (int mt = 0; mt < 4; ++mt) O[mt] = MFMA32(vt_frag(ldsV, mt, kt, s, lane), pb, O[mt]);
            }
    }
    l += __shfl_xor(l, 32);
    const float inv = 1.0f / l;
    u32x4* xch = (u32x4*)xch_lds;
    __syncthreads();
    if (br == 1) {
#pragma unroll
        for (int mt = 0; mt < 4; ++mt)
#pragma unroll
            for (int g = 0; g < 4; ++g) {
                const f32x4 o = {O[mt][4 * g] * inv, O[mt][4 * g + 1] * inv, O[mt][4 * g + 2] * inv, O[mt][4 * g + 3] * inv};
                xch[(mt * 4 + g) * 256 + tid] = __builtin_bit_cast(u32x4, o);
            }
    }
    __syncthreads();
    if (br == 0) {
        float ss = 0.f;
#pragma unroll
        for (int mt = 0; mt < 4; ++mt)
#pragma unroll
            for (int g = 0; g < 4; ++g) {
                const f32x4 o2 = __builtin_bit_cast(f32x4, xch[(mt * 4 + g) * 256 + tid]);
#pragma unroll
                for (int e = 0; e < 4; ++e) { const float t = O[mt][4 * g + e] * inv - lam * o2[e]; ss += t * t; }
            }
        ss += __shfl_xor(ss, 32);
        const float rstd = rsqrtf(ss * (1.0f / 128.0f) + 1e-6f) * osc;
        bf16_t* yp = (bf16_t*)(p->ws + Y_OFF) + (size_t)(b * SEQ + qpos) * 1024 + 512 + head * 128 + 4 * h;
#pragma unroll
        for (int mt = 0; mt < 4; ++mt)
#pragma unroll
            for (int g = 0; g < 4; ++g) {
                const f32x4 o2 = __builtin_bit_cast(f32x4, xch[(mt * 4 + g) * 256 + tid]);
                const f32x4 sg = *(const f32x4*)(subln + mt * 32 + 8 * g + 4 * h);
                f32x4 t;
#pragma unroll
                for (int e = 0; e < 4; ++e) t[e] = (O[mt][4 * g + e] * inv - lam * o2[e]) * sg[e] * rstd;
                u32x2 wv; wv.x = pk_bf16(t[0], t[1]); wv.y = pk_bf16(t[2], t[3]);
                *(u32x2*)(yp + mt * 32 + 8 * g) = wv;
            }
    }
}

__device__ __forceinline__ void sb_attn_unit(KP p, int b, int head, int qi, unsigned char* smem, volatile int* flags) {
    const int tid = get_tid(), lane = tid & 63, w = tid >> 6, r = lane & 31, h = lane >> 5;
    const bf16_t* P = (const bf16_t*)(p->ws + P_OFF);
    const bf16_t* VT = (const bf16_t*)(p->ws + VT_OFF) + ((size_t)b * 1024 + head * 64) * SEQ;
    bf16_t* Y = (bf16_t*)(p->ws + Y_OFF);
    const bf16_t* Pq = P + (size_t)(b * SEQ) * 2048 + head * 64;
    const bf16_t* Pk = P + (size_t)(b * SEQ) * 2048 + 1024 + head * 64;
    const int q0w = qi * 128 + w * 32;
    const int qpos = q0w + r;
    bf16x8 qf[4];
#pragma unroll
    for (int ks = 0; ks < 4; ++ks) qf[ks] = *(const bf16x8*)(Pq + (size_t)qpos * 2048 + ks * 16 + h * 8);
    f32x16 O[2];
#pragma unroll
    for (int mt = 0; mt < 2; ++mt)
#pragma unroll
        for (int i = 0; i < 16; ++i) O[mt][i] = 0.f;
    float carry = 0.f;
    unsigned char* ldsK = smem; unsigned char* ldsV = smem + 8192;
    u32x4 rk[2], rv[2];
    int c = 2 * qi + 1;
    k64_load(rk, Pk + (size_t)(c * 64) * 2048, 2048);
    vt_load<2>(rv, VT + c * 64, SEQ);
    int done = 0;
    const int w8 = w + 4 * vhalf();
    for (; c >= 0; --c) {
        const int wd = __all(done);
        if (lane == 0) flags[w8] = wd;
        __syncthreads();
        if (flags[0] & flags[1] & flags[2] & flags[3] & flags[4] & flags[5] & flags[6] & flags[7]) break;
        k64_store(rk, ldsK); vt_store<2>(rv, ldsV);
        __syncthreads();
        if (c > 0) { k64_load(rk, Pk + (size_t)((c - 1) * 64) * 2048, 2048); vt_load<2>(rv, VT + (c - 1) * 64, SEQ); }
        const int key0 = c * 64;
        if (key0 > q0w + 31) continue;
        f32x16 S[2];
#pragma unroll
        for (int kt = 0; kt < 2; ++kt) {
#pragma unroll
            for (int i = 0; i < 16; ++i) S[kt][i] = 0.f;
#pragma unroll
            for (int ks = 0; ks < 4; ++ks) S[kt] = MFMA32(k64_frag(ldsK, kt, ks, lane), qf[ks], S[kt]);
        }
        const int lim = qpos - key0 - 4 * h;
        f32x16 LB[2];
        float run[8];
#pragma unroll
        for (int kt = 0; kt < 2; ++kt)
#pragma unroll
            for (int g = 0; g < 4; ++g) {
                float rs = 0.f;
#pragma unroll
                for (int e = 0; e < 4; ++e) {
                    const int i = 4 * g + e;
                    const float z2 = S[kt][i] * LOG2E;
                    const float t = flog2(1.0f + fexp2(-fabsf(z2)));
                    const float lb = fminf(z2, 0.f) - t;
                    float l1 = lb - z2;
                    const bool valid = (kt * 32 + 8 * g + e) < lim;
                    if (!valid) l1 = 0.f;
                    LB[kt][i] = valid ? lb : -INFINITY;
                    S[kt][i] = l1;
                    rs += l1;
                }
                run[kt * 4 + g] = rs;
            }
        float oth[8], tot[8];
#pragma unroll
        for (int G = 0; G < 8; ++G) { oth[G] = __shfl_xor(run[G], 32); tot[G] = run[G] + oth[G]; }
        float suf = carry;
#pragma unroll
        for (int G = 7; G >= 0; --G) {
            const int kt = G >> 2, g = G & 3;
            float tail = suf + (h == 0 ? oth[G] : 0.f);
#pragma unroll
            for (int e = 3; e >= 0; --e) {
                const int i = 4 * g + e;
                const float l1 = S[kt][i];
                S[kt][i] = fexp2(LB[kt][i] + tail);
                tail += l1;
            }
            suf += tot[G];
        }
        carry = suf;
#pragma unroll
        for (int kt = 0; kt < 2; ++kt)
#pragma unroll
            for (int s = 0; s < 2; ++s) {
                const bf16x8 pb = pack8(S[kt], s);
#pragma unroll
                for (int mt = 0; mt < 2; ++mt) O[mt] = MFMA32(vt_frag(ldsV, mt, kt, s, lane), pb, O[mt]);
            }
        done = (carry < -160.0f);
    }
    __syncthreads();
    bf16_t* op = Y + (size_t)(b * SEQ + qpos) * 1024 + head * 64;
#pragma unroll
    for (int mt = 0; mt < 2; ++mt)
#pragma unroll
        for (int g = 0; g < 4; ++g) {
            u32x2 wv; wv.x = pk_bf16(O[mt][4 * g], O[mt][4 * g + 1]); wv.y = pk_bf16(O[mt][4 * g + 2], O[mt][4 * g + 3]);
            *(u32x2*)(op + mt * 32 + 8 * g + 4 * h) = wv;
        }
}

__device__ __forceinline__ bf16x8 k256_frag(const unsigned char* lds, int kt, int ks, int lane) {
    const int r = lane & 31, h = lane >> 5;
    const int row = kt * 32 + r;
    const int ch = ks * 2 + h;
    return *(const bf16x8*)(lds + row * 512 + ((((ch & 15) ^ (row & 15)) | (ch & 16)) << 4));
}
__device__ __forceinline__ void cross_attn_unit(KP p, int layer, int b, int head, int qi, unsigned char* smem) {
    const int tid = get_tid(), lane = tid & 63, w = tid >> 6, r = lane & 31, h = lane >> 5;
    const bf16_t* Qx = (const bf16_t*)(p->ws + QX_OFF);
    const bf16_t* Km = (const bf16_t*)(p->ws + KM_OFF) + (size_t)layer * 1048576 + (size_t)(b * 256) * 1024 + head * 256;
    const bf16_t* VT = (const bf16_t*)(p->ws + VTM_OFF) + (size_t)layer * 1048576 + ((size_t)b * 1024 + head * 256) * 256;
    bf16_t* Yx = (bf16_t*)(p->ws + YX_OFF);
    const float* qg = p->in[17] + layer * 256;
    const int qpos = qi * 128 + w * 32 + r;
    const bf16_t* qrow = Qx + (size_t)(b * SEQ + qpos) * 1024 + head * 256;
    bf16x8 qf[16];
    {
        float ss = 0.f;
#pragma unroll
        for (int ks = 0; ks < 16; ++ks) {
            const u32x4 v = *(const u32x4*)(qrow + ks * 16 + h * 8);
            qf[ks] = __builtin_bit_cast(bf16x8, v);
            ss += bf_lo(v.x) * bf_lo(v.x) + bf_hi(v.x) * bf_hi(v.x) + bf_lo(v.y) * bf_lo(v.y) + bf_hi(v.y) * bf_hi(v.y)
                + bf_lo(v.z) * bf_lo(v.z) + bf_hi(v.z) * bf_hi(v.z) + bf_lo(v.w) * bf_lo(v.w) + bf_hi(v.w) * bf_hi(v.w);
        }
        ss += __shfl_xor(ss, 32);
        const float sc = rsqrtf(ss * (1.0f / 256.0f) + 1e-6f) * (0.0625f * LOG2E);
#pragma unroll
        for (int ks = 0; ks < 16; ++ks) {
            const u32x4 v = __builtin_bit_cast(u32x4, qf[ks]);
            const f32x4 ga = *(const f32x4*)(qg + ks * 16 + h * 8), gb = *(const f32x4*)(qg + ks * 16 + h * 8 + 4);
            u32x4 o;
            o.x = pk_bf16(bf_lo(v.x) * ga[0] * sc, bf_hi(v.x) * ga[1] * sc);
            o.y = pk_bf16(bf_lo(v.y) * ga[2] * sc, bf_hi(v.y) * ga[3] * sc);
            o.z = pk_bf16(bf_lo(v.z) * gb[0] * sc, bf_hi(v.z) * gb[1] * sc);
            o.w = pk_bf16(bf_lo(v.w) * gb[2] * sc, bf_hi(v.w) * gb[3] * sc);
            qf[ks] = __builtin_bit_cast(bf16x8, o);
        }
    }
    unsigned char* ldsK = smem; unsigned char* ldsV = smem + 32768;
    bf16_t* op = Yx + (size_t)(b * SEQ + qpos) * 1024 + head * 256;
    const int krow = tid >> 2, kc0 = (tid & 3) * 8;
    for (int dvh = 0; dvh < 2; ++dvh) {
        f32x16 O[4];
#pragma unroll
        for (int mt = 0; mt < 4; ++mt)
#pragma unroll
            for (int i = 0; i < 16; ++i) O[mt][i] = 0.f;
        float m = -1e30f, l = 0.f;
        for (int c = 0; c < 4; ++c) {
            __syncthreads();
            {
                const bf16_t* kg = Km + (size_t)(c * 64 + krow) * 1024 + kc0 * 8;
#pragma unroll
                for (int j = 0; j < 8; ++j) {
                    const u32x4 v = *(const u32x4*)(kg + j * 8);
                    const int ch = kc0 + j;
                    *(u32x4*)(ldsK + krow * 512 + ((((ch & 15) ^ (krow & 15)) | (ch & 16)) << 4)) = v;
                }
                u32x4 rv[4];
                vt_load<4>(rv, VT + (size_t)(dvh * 128) * 256 + c * 64, 256);
                vt_store<4>(rv, ldsV);
            }
            __syncthreads();
            f32x16 S[2];
#pragma unroll
            for (int kt = 0; kt < 2; ++kt) {
#pragma unroll
                for (int i = 0; i < 16; ++i) S[kt][i] = 0.f;
#pragma unroll
                for (int ks = 0; ks < 16; ++ks) S[kt] = MFMA32(k256_frag(ldsK, kt, ks, lane), qf[ks], S[kt]);
            }
            float mx;
            {
                float m0 = -1e30f, m1 = -1e30f, m2 = -1e30f, m3 = -1e30f;
#pragma unroll
                for (int kt = 0; kt < 2; ++kt)
#pragma unroll
                    for (int i = 0; i < 16; i += 4) { m0 = fmaxf(m0, S[kt][i]); m1 = fmaxf(m1, S[kt][i + 1]); m2 = fmaxf(m2, S[kt][i + 2]); m3 = fmaxf(m3, S[kt][i + 3]); }
                mx = fmaxf(fmaxf(m0, m1), fmaxf(m2, m3));
            }
            mx = fmaxf(mx, __shfl_xor(mx, 32));
            const float mn = fmaxf(m, mx);
            const float alpha = fexp2(m - mn);
            m = mn;
            float ls;
            {
                float l0 = 0.f, l1 = 0.f, l2 = 0.f, l3 = 0.f;
#pragma unroll
                for (int kt = 0; kt < 2; ++kt)
#pragma unroll
                    for (int i = 0; i < 16; i += 4) {
                        const float p0 = fexp2(S[kt][i] - mn), p1 = fexp2(S[kt][i + 1] - mn), p2 = fexp2(S[kt][i + 2] - mn), p3 = fexp2(S[kt][i + 3] - mn);
                        S[kt][i] = p0; S[kt][i + 1] = p1; S[kt][i + 2] = p2; S[kt][i + 3] = p3;
                        l0 += p0; l1 += p1; l2 += p2; l3 += p3;
                    }
                ls = (l0 + l1) + (l2 + l3);
            }
            l = l * alpha + ls;
#pragma unroll
            for (int mt = 0; mt < 4; ++mt)
#pragma unroll
                for (int i = 0; i < 16; ++i) O[mt][i] *= alpha;
#pragma unroll
            for (int kt = 0; kt < 2; ++kt)
#pragma unroll
                for (int s = 0; s < 2; ++s) {
                    const bf16x8 pb = pack8(S[kt], s);
#pragma unroll
                    for (int mt = 0; mt < 4; ++mt) O[mt] = MFMA32(vt_frag(ldsV, mt, kt, s, lane), pb, O[mt]);
                }
        }
        l += __shfl_xor(l, 32);
        const float inv = 1.0f / l;
#pragma unroll
        for (int mt = 0; mt < 4; ++mt)
#pragma unroll
            for (int g = 0; g < 4; ++g) {
                u32x2 wv; wv.x = pk_bf16(O[mt][4 * g] * inv, O[mt][4 * g + 1] * inv); wv.y = pk_bf16(O[mt][4 * g + 2] * inv, O[mt][4 * g + 3] * inv);
                *(u32x2*)(op + dvh * 128 + mt * 32 + 8 * g + 4 * h) = wv;
            }
    }
}

__device__ __forceinline__ void norm_rows(const float* src, const float* gain, bf16_t* dst, float* copy, int nrows) {
    const int lane = get_tid() & 63;
    const int nw = nvb() * 4;
    for (int rr = vbid() * 4 + (get_tid() >> 6); rr < nrows; rr += nw) {
        const f32x4* s = (const f32x4*)(src + (size_t)rr * 1024);
        f32x4 v[4]; float ss = 0.f;
#pragma unroll
        for (int i = 0; i < 4; ++i) { v[i] = s[lane + 64 * i]; ss += v[i][0] * v[i][0] + v[i][1] * v[i][1] + v[i][2] * v[i][2] + v[i][3] * v[i][3]; }
        ss = wave_sum(ss);
        const float rstd = rsqrtf(ss * (1.0f / 1024.0f) + 1e-6f);
#pragma unroll
        for (int i = 0; i < 4; ++i) {
            const f32x4 g = ((const f32x4*)gain)[lane + 64 * i];
            u32x2 o; o.x = pk_bf16(v[i][0] * rstd * g[0], v[i][1] * rstd * g[1]); o.y = pk_bf16(v[i][2] * rstd * g[2], v[i][3] * rstd * g[3]);
            ((u32x2*)(dst + (size_t)rr * 1024))[lane + 64 * i] = o;
            if (copy) ((f32x4*)(copy + (size_t)rr * 1024))[lane + 64 * i] = v[i];
        }
    }
}

__device__ __forceinline__ void wconv_tile(const float* W, bf16_t* Wt, int K, int N, int tile, unsigned char* smem, const float* gk = nullptr) {
    float* lds = (float*)smem;
    const int tid = get_tid();
    const int ntn = N >> 6;
    const int k0 = (tile / ntn) * 64, n0 = (tile % ntn) * 64;
    __syncthreads();
#pragma unroll
    for (int i = 0; i < 4; ++i) {
        const int idx = tid + 256 * i, kr = idx >> 4, c4 = idx & 15;
        f32x4 v = *(const f32x4*)(W + (size_t)(k0 + kr) * N + n0 + c4 * 4);
        if (gk) v = v * gk[k0 + kr];
        lds[kr * 65 + c4 * 4 + 0] = v[0]; lds[kr * 65 + c4 * 4 + 1] = v[1]; lds[kr * 65 + c4 * 4 + 2] = v[2]; lds[kr * 65 + c4 * 4 + 3] = v[3];
    }
    __syncthreads();
#pragma unroll
    for (int i = 0; i < 2; ++i) {
        const int idx = tid + 256 * i, n = idx >> 3, kc = idx & 7;
        u32x4 o;
        o.x = pk_bf16(lds[(kc * 8 + 0) * 65 + n], lds[(kc * 8 + 1) * 65 + n]);
        o.y = pk_bf16(lds[(kc * 8 + 2) * 65 + n], lds[(kc * 8 + 3) * 65 + n]);
        o.z = pk_bf16(lds[(kc * 8 + 4) * 65 + n], lds[(kc * 8 + 5) * 65 + n]);
        o.w = pk_bf16(lds[(kc * 8 + 6) * 65 + n], lds[(kc * 8 + 7) * 65 + n]);
        *(u32x4*)(Wt + (size_t)(n0 + n) * K + k0 + kc * 8) = o;
    }
}

__device__ __forceinline__ void ya_unit(KP p, int e, int unit) {
    const int tid = get_tid(), cgp = tid & 63, w = tid >> 6;
    const bf16_t* P = (const bf16_t*)(p->ws + P_OFF);
    bf16_t* Y = (bf16_t*)(p->ws + Y_OFF);
    const float* cw = p->in[7] + (size_t)e * 3 * 512;
    float w0[8], w1[8], w2[8];
#pragma unroll
    for (int j = 0; j < 8; ++j) { w0[j] = cw[cgp * 8 + j]; w1[j] = cw[512 + cgp * 8 + j]; w2[j] = cw[1024 + cgp * 8 + j]; }
    const int t0 = unit * 32 + w * 8;
    float p1[8], p2[8];
#pragma unroll
    for (int j = 0; j < 8; ++j) { p1[j] = 0.f; p2[j] = 0.f; }
#pragma unroll
    for (int dt = -2; dt < 8; ++dt) {
        const int t = t0 + dt;
        float pr[8];
        const bool inseq = (t >= 0) && ((t & (SEQ - 1)) <= ((t0 + 7) & (SEQ - 1)));
        if (inseq) {
            const u32x4 c = *(const u32x4*)(P + (size_t)t * 2560 + 512 + cgp * 8);
            const u32x4 x = *(const u32x4*)(P + (size_t)t * 2560 + 1024 + cgp * 8);
            pr[0] = bf_lo(c.x) * bf_lo(x.x); pr[1] = bf_hi(c.x) * bf_hi(x.x); pr[2] = bf_lo(c.y) * bf_lo(x.y); pr[3] = bf_hi(c.y) * bf_hi(x.y);
            pr[4] = bf_lo(c.z) * bf_lo(x.z); pr[5] = bf_hi(c.z) * bf_hi(x.z); pr[6] = bf_lo(c.w) * bf_lo(x.w); pr[7] = bf_hi(c.w) * bf_hi(x.w);
        } else {
#pragma unroll
            for (int j = 0; j < 8; ++j) pr[j] = 0.f;
        }
        if (dt >= 0) {
            const u32x4 bb = *(const u32x4*)(P + (size_t)t * 2560 + cgp * 8);
            float o[8];
#pragma unroll
            for (int j = 0; j < 8; ++j) o[j] = w2[j] * pr[j] + w1[j] * p1[j] + w0[j] * p2[j];
            u32x4 ov;
            ov.x = pk_bf16(bf_lo(bb.x) * o[0], bf_hi(bb.x) * o[1]); ov.y = pk_bf16(bf_lo(bb.y) * o[2], bf_hi(bb.y) * o[3]);
            ov.z = pk_bf16(bf_lo(bb.z) * o[4], bf_hi(bb.z) * o[5]); ov.w = pk_bf16(bf_lo(bb.w) * o[6], bf_hi(bb.w) * o[7]);
            *(u32x4*)(Y + (size_t)t * 1024 + cgp * 8) = ov;
        }
#pragma unroll
        for (int j = 0; j < 8; ++j) { p2[j] = p1[j]; p1[j] = pr[j]; }
    }
}

__device__ __forceinline__ void combine_rows(KP p, int layer, int e) {
    const int lane = get_tid() & 63;
    const float lam_init = 0.8f - 0.6f * expf(-0.3f * (float)layer);
    const float* lv = p->in[10] + (size_t)e * 256;
    float a = lv[lane] * lv[64 + lane], bq = lv[128 + lane] * lv[192 + lane];
    a = wave_sum(a); bq = wave_sum(bq);
    const float lam = expf(a) - expf(bq) + lam_init;
    const float* sub = p->in[11] + (size_t)e * 128 + (lane & 15) * 8;
    float sg[8];
#pragma unroll
    for (int j = 0; j < 8; ++j) sg[j] = sub[j] * (1.0f - lam_init);
    const bf16_t* O12 = (const bf16_t*)(p->ws + O12_OFF);
    bf16_t* Y = (bf16_t*)(p->ws + Y_OFF);
    const int nw = nvb() * 4;
    for (int t = vbid() * 4 + (get_tid() >> 6); t < NTOK; t += nw) {
        const u32x4 a1 = *(const u32x4*)(O12 + (size_t)t * 1024 + lane * 8);
        const u32x4 a2 = *(const u32x4*)(O12 + (size_t)t * 1024 + 512 + lane * 8);
        float d[8];
        d[0] = bf_lo(a1.x) - lam * bf_lo(a2.x); d[1] = bf_hi(a1.x) - lam * bf_hi(a2.x);
        d[2] = bf_lo(a1.y) - lam * bf_lo(a2.y); d[3] = bf_hi(a1.y) - lam * bf_hi(a2.y);
        d[4] = bf_lo(a1.z) - lam * bf_lo(a2.z); d[5] = bf_hi(a1.z) - lam * bf_hi(a2.z);
        d[6] = bf_lo(a1.w) - lam * bf_lo(a2.w); d[7] = bf_hi(a1.w) - lam * bf_hi(a2.w);
        float ss = 0.f;
#pragma unroll
        for (int j = 0; j < 8; ++j) ss += d[j] * d[j];
        ss += __shfl_xor(ss, 1); ss += __shfl_xor(ss, 2); ss += __shfl_xor(ss, 4); ss += __shfl_xor(ss, 8);
        const float rstd = rsqrtf(ss * (1.0f / 128.0f) + 1e-6f);
        u32x4 o;
        o.x = pk_bf16(d[0] * rstd * sg[0], d[1] * rstd * sg[1]); o.y = pk_bf16(d[2] * rstd * sg[2], d[3] * rstd * sg[3]);
        o.z = pk_bf16(d[4] * rstd * sg[4], d[5] * rstd * sg[5]); o.w = pk_bf16(d[6] * rstd * sg[6], d[7] * rstd * sg[7]);
        *(u32x4*)(Y + (size_t)t * 1024 + 512 + lane * 8) = o;
    }
}

__device__ __forceinline__ void knorm_rows(KP p, int layer, int first, int nwaves) {
    const int lane = get_tid() & 63;
    bf16_t* Km = (bf16_t*)(p->ws + KM_OFF) + (size_t)layer * 1048576;
    const float* kg = p->in[18] + layer * 256;
    for (int it = first; it < 4096; it += nwaves) {
        bf16_t* row = Km + (size_t)(it >> 2) * 1024 + (it & 3) * 256 + lane * 4;
        const u32x2 v = *(const u32x2*)row;
        float x0 = bf_lo(v.x), x1 = bf_hi(v.x), x2 = bf_lo(v.y), x3 = bf_hi(v.y);
        float ss = wave_sum(x0 * x0 + x1 * x1 + x2 * x2 + x3 * x3);
        const float rstd = rsqrtf(ss * (1.0f / 256.0f) + 1e-6f);
        const f32x4 g = *(const f32x4*)(kg + lane * 4);
        u32x2 o; o.x = pk_bf16(x0 * rstd * g[0], x1 * rstd * g[1]); o.y = pk_bf16(x2 * rstd * g[2], x3 * rstd * g[3]);
        *(u32x2*)row = o;
    }
}

__device__ __forceinline__ void ffn_gate(KP p, int layer) {
    const float* Us = (const float*)(p->ws + US_OFF);
    bf16_t* G = (bf16_t*)(p->ws + G_OFF);
    const float* cw = p->in[21] + (size_t)layer * 3 * 5632;
    const int nitems = 128 * 2 * 704;
    for (int it = vbid() * 256 + get_tid(); it < nitems; it += nvb() * 256) {
        const int cq = it % 704, rr = (it / 704) & 1, gb = it / 1408;
        const int ch = cq * 4;
        const bool hasp = (gb & 31) != 0;
        const f32x4 z = {0.f, 0.f, 0.f, 0.f};
        const float* u0 = Us + (size_t)(gb * 4 + rr) * 5632;
        const float* pl1 = Us + (size_t)((gb - 1) * 4 + 3) * 5632;
        const float* pl2 = Us + (size_t)((gb - 1) * 4 + 2) * 5632;
        const f32x4 g0 = *(const f32x4*)(u0 + ch), v0 = *(const f32x4*)(u0 + 2816 + ch);
        f32x4 g1, g2, v1, v2;
        if (rr == 1) {
            g1 = *(const f32x4*)(Us + (size_t)(gb * 4) * 5632 + ch); v1 = *(const f32x4*)(Us + (size_t)(gb * 4) * 5632 + 2816 + ch);
            g2 = hasp ? *(const f32x4*)(pl1 + ch) : z; v2 = hasp ? *(const f32x4*)(pl1 + 2816 + ch) : z;
        } else {
            g1 = hasp ? *(const f32x4*)(pl1 + ch) : z; v1 = hasp ? *(const f32x4*)(pl1 + 2816 + ch) : z;
            g2 = hasp ? *(const f32x4*)(pl2 + ch) : z; v2 = hasp ? *(const f32x4*)(pl2 + 2816 + ch) : z;
        }
        const f32x4 wg0 = *(const f32x4*)(cw + ch), wg1 = *(const f32x4*)(cw + 5632 + ch), wg2 = *(const f32x4*)(cw + 11264 + ch);
        const f32x4 wv0 = *(const f32x4*)(cw + 2816 + ch), wv1 = *(const f32x4*)(cw + 5632 + 2816 + ch), wv2 = *(const f32x4*)(cw + 11264 + 2816 + ch);
        const f32x4 cg = wg2 * g0 + wg1 * g1 + wg0 * g2;
        const f32x4 cv = wv2 * v0 + wv1 * v1 + wv0 * v2;
        f32x4 o;
#pragma unroll
        for (int e = 0; e < 4; ++e) o[e] = cg[e] * __builtin_amdgcn_rcpf(1.0f + fexp2(-LOG2E * cg[e])) * cv[e];
        u32x2 w; w.x = pk_bf16(o[0], o[1]); w.y = pk_bf16(o[2], o[3]);
        *(u32x2*)(G + (size_t)(gb * 128 + rr) * 2816 + ch) = w;
    }
}

#define XB_TMO      128
#define XB_XCNT(j)  (256  + 64 * (j))
#define XB_XSUB(j)  (1280 + 64 * (j))
#define XB_XGEN(j)  (2304 + 64 * (j))
#define XB_TOP      3328
#define XB_TOPGEN   3392
#define XCD_BAR_WORDS 3456
#define XB_SPIN_CAP (1u << 22)
#define LAS __attribute__((address_space(3)))
__device__ __forceinline__ unsigned xb_ld(unsigned* p)              { return __hip_atomic_load(p, __ATOMIC_RELAXED, __HIP_MEMORY_SCOPE_AGENT); }
__device__ __forceinline__ unsigned xb_add(unsigned* p, unsigned v) { return __hip_atomic_fetch_add(p, v, __ATOMIC_RELAXED, __HIP_MEMORY_SCOPE_AGENT); }
__device__ __forceinline__ unsigned xb_xcc_id() { return (unsigned)__builtin_amdgcn_s_getreg((3 << 11) | 20) & 0xFu; }
#define XB_SPIN(cond, bar) do { unsigned _sp = 0; while (cond) { __builtin_amdgcn_s_sleep(1); \
    if ((++_sp & 255u) == 0u) { if (xb_ld(&(bar)[XB_TMO])) break; if (_sp > XB_SPIN_CAP) { atomicAdd(&(bar)[XB_TMO], 1u); break; } } } } while (0)
struct XcdBarrier { unsigned* bar; unsigned x; volatile LAS unsigned* st; };
__device__ __forceinline__ XcdBarrier xcd_barrier_post(unsigned* bar, volatile LAS unsigned* st) {
    XcdBarrier b; b.bar = bar; b.x = xb_xcc_id(); b.st = st;
    if (threadIdx.x == 0) (void)xb_add(&bar[XB_XCNT(b.x)], 1u);
    return b;
}
__device__ __forceinline__ void xcd_barrier_complete(unsigned* bar, unsigned x, unsigned& nloc, unsigned& nx) {
    const unsigned G = gridDim.x * gridDim.y * gridDim.z;
    unsigned sum, cnt, mine, sp = 0u;
    for (;;) {
        sum = 0u; cnt = 0u; mine = 0u;
#pragma unroll
        for (unsigned j = 0; j < 16; ++j) { const unsigned c = xb_ld(&bar[XB_XCNT(j)]); sum += c; cnt += (c > 0u) ? 1u : 0u; mine = (j == x) ? c : mine; }
        if (sum == G) break;
        __builtin_amdgcn_s_sleep(1);
        if ((++sp & 255u) == 0u) { if (xb_ld(&bar[XB_TMO])) break; if (sp > XB_SPIN_CAP) { atomicAdd(&bar[XB_TMO], 1u); break; } }
    }
    nloc = mine > 0u ? mine : 1u; nx = cnt > 0u ? cnt : 1u;
}
__device__ __forceinline__ void xcd_barrier(const XcdBarrier& b) {
    asm volatile("s_waitcnt vmcnt(0)" ::: "memory");
    __syncthreads();
    if (threadIdx.x == 0) {
        unsigned* bar = b.bar;
        __builtin_amdgcn_s_waitcnt(0);
        unsigned nloc = b.st[0], nx = b.st[1];
        if (nloc == 0u) { xcd_barrier_complete(bar, b.x, nloc, nx); b.st[0] = nloc; b.st[1] = nx; }
        const unsigned old = xb_add(&bar[XB_XSUB(b.x)], 1u);
        const unsigned gen = old / nloc;
        if (old + 1u == (gen + 1u) * nloc) {
            __builtin_amdgcn_fence(__ATOMIC_RELEASE, "agent");
            asm volatile("s_waitcnt vmcnt(0)" ::: "memory");
            const unsigned og = xb_add(&bar[XB_TOP], 1u);
            const unsigned tg = og / nx;
            if (og + 1u == (tg + 1u) * nx) xb_add(&bar[XB_TOPGEN], 1u);
            else XB_SPIN(xb_ld(&bar[XB_TOPGEN]) == tg, bar);
            __builtin_amdgcn_fence(__ATOMIC_ACQUIRE, "agent");
            xb_add(&bar[XB_XGEN(b.x)], 1u);
            asm volatile("s_waitcnt vmcnt(0)" ::: "memory");
        } else {
            XB_SPIN(xb_ld(&bar[XB_XGEN(b.x)]) == gen, bar);
            __builtin_amdgcn_fence(__ATOMIC_ACQUIRE, "agent");
            asm volatile("s_waitcnt vmcnt(0)" ::: "memory");
        }
    }
    __syncthreads();
}

#define NPH 13
struct GemmCnt { int c0, c1, c2, T; };
__device__ __forceinline__ void gemm_desc(KP p, int layer, int ph, int t, const GemmCnt& cn, GemmD& d, int& tm, int& tn) {
    const bool even = (layer & 1) == 0;
    unsigned char* ws = p->ws;
    const bf16_t* H = (const bf16_t*)(ws + H_OFF);
    const bf16_t* MH = (const bf16_t*)(ws + MH_OFF);
    const int c0 = cn.c0, c1 = cn.c1, c2 = cn.c2, T = cn.T;
    const int v = (t & 7) * (T >> 3) + (t >> 3);
        d.mode = 0; d.colblk = 0; d.cbstride = 0; d.g0 = nullptr; d.g1 = nullptr; d.aux = nullptr;
    d.rss = (const float*)(ws + RSS_OFF); d.rsmode = 0; d.nq0 = 0; d.nq1 = 0; d.nsc0 = 0; d.nsplit = 0; d.qscale = 1.f;
        d.lda = 1024; d.ldb = 1024; d.K = 1024;
        int u = v;
        if (ph == 1) {
            if (v < c0) {
                d.A = H; d.B = (const bf16_t*)(ws + WT_IN_OFF); d.MT = 64; d.NT = even ? 10 : 8; d.mode = 2;
                d.rss = (const float*)(ws + RSS_OFF) + (size_t)(3 * layer) * RSS_SLOT; d.rsmode = 1;
                d.C = ws + P_OFF; d.ldc = even ? 2560 : 2048;
                if (even) { const int e = layer >> 1; d.nq0 = 1536; d.nq1 = 2560; d.nsc0 = 1536; d.nsplit = 2048; d.g0 = p->in[8] + e * 64; d.g1 = p->in[9] + e * 64; d.qscale = 0.125f * LOG2E; }
                else { d.nq0 = 0; d.nq1 = 0; d.nsc0 = 0; d.nsplit = 1024; d.qscale = 0.125f; }
            } else if (v < c0 + c1) {
                u = v - c0;
                const int nv = even ? 512 : 1024;
                d.A = (const bf16_t*)(ws + WT_IN_OFF) + (size_t)(even ? 2560 : 2048) * 1024; d.B = H; d.MT = nv / 256; d.NT = 64;
                d.rss = (const float*)(ws + RSS_OFF) + (size_t)(3 * layer) * RSS_SLOT; d.rsmode = 2;
                d.C = ws + VT_OFF; d.ldc = SEQ; d.colblk = SEQ; d.cbstride = (long)nv * SEQ;
            } else if (v < c0 + c1 + c2) {
                u = v - c0 - c1;
                const int lm = u >> 4; u &= 15;
                d.A = MH + (size_t)lm * 1048576; d.B = (const bf16_t*)(ws + WTKV4_OFF) + (size_t)lm * 2097152; d.MT = 4; d.NT = 4;
                d.C = ws + KM_OFF + (size_t)lm * 2097152; d.ldc = 1024;
            } else {
                u = v - c0 - c1 - c2;
                const int lm = u >> 4; u &= 15;
                d.A = (const bf16_t*)(ws + WTKV4_OFF) + (size_t)lm * 2097152 + (size_t)1024 * 1024; d.B = MH + (size_t)lm * 1048576; d.MT = 4; d.NT = 4;
                d.C = ws + VTM_OFF + (size_t)lm * 2097152; d.ldc = 256; d.colblk = 256; d.cbstride = 1024L * 256;
            }
        } else if (ph == 4) {
            d.A = (const bf16_t*)(ws + Y_OFF); d.B = (const bf16_t*)(ws + WT_OUT_OFF); d.MT = 64; d.NT = 4; d.mode = 1; d.C = p->X; d.ldc = 1024;
            d.aux = (float*)(ws + RSS_OFF) + (size_t)(3 * layer + 1) * RSS_SLOT; d.g1 = (const float*)(ws + H_OFF);
        } else if (ph == 6) {
            d.A = H; d.B = (const bf16_t*)(ws + WT_XQ_OFF); d.MT = 64; d.NT = 4; d.C = ws + QX_OFF; d.ldc = 1024;
            d.rss = (const float*)(ws + RSS_OFF) + (size_t)(3 * layer + 1) * RSS_SLOT; d.rsmode = 1;
        } else if (ph == 8) {
            d.A = (const bf16_t*)(ws + YX_OFF); d.B = (const bf16_t*)(ws + WT_XO_OFF); d.MT = 64; d.NT = 4; d.mode = 1; d.C = p->X; d.ldc = 1024;
            d.aux = (float*)(ws + RSS_OFF) + (size_t)(3 * layer + 2) * RSS_SLOT; d.g1 = (const float*)(ws + H_OFF);
        } else if (ph == 10) {
            d.A = H; d.B = (const bf16_t*)(ws + WT_UP_OFF); d.MT = 64; d.NT = 22; d.mode = 4; d.C = ws + G_OFF; d.ldc = 2816; d.rss = (const float*)(ws + RSS_OFF) + (size_t)(3 * layer + 2) * RSS_SLOT; d.rsmode = 1; d.g0 = p->in[21] + (size_t)layer * 3 * 5632; d.aux = (float*)(ws + US_OFF);
        } else {
            d.A = (const bf16_t*)(ws + G_OFF); d.B = (const bf16_t*)(ws + WT_DOWN_OFF); d.lda = 2816; d.ldb = 2816; d.K = 2816;
            d.MT = 64; d.NT = 4; d.mode = 1; d.C = p->X; d.ldc = 1024;
            d.aux = (float*)(ws + RSS_OFF) + (size_t)(3 * layer + 3) * RSS_SLOT; d.g1 = (const float*)(ws + H_OFF);
        }
        tile_map(u, d.MT, d.NT, tm, tn);
}

#define GEMM_RSRC(P) __builtin_amdgcn_make_buffer_rsrc((void*)(P), 0, 0x7fffffff, 0x00020000)
typedef __attribute__((address_space(3))) void* lds_ptr_t;
#define GEMM_DMA1(PA, PB, BROWB, BUF, KOFS, i_) do { \
        const int soa_ = (KOFS) + (wid * 32 + (i_) * 8) * ld * 2; \
        const int sob_ = (KOFS) + (BROWB) + (i_) * 8 * ld * 2; \
        __builtin_amdgcn_raw_ptr_buffer_load_lds((PA), (lds_ptr_t)((BUF) + (wid * 4 + (i_)) * 1024), 16, ((i_) & 1) ? vodd : veven, soa_, 0, 0); \
        __builtin_amdgcn_raw_ptr_buffer_load_lds((PB), (lds_ptr_t)((BUF) + 32768 + (wid * 4 + (i_)) * 1024), 16, ((i_) & 1) ? vodd : veven, sob_, 0, 0); } while (0)
#define GEMM_DMA(PA, PB, BROWB, BUF, KOFS) do { _Pragma("unroll") for (int i_ = 0; i_ < 4; ++i_) GEMM_DMA1(PA, PB, BROWB, BUF, KOFS, i_); } while (0)
#define GEMM_STEP(BUF, DO_DMA, PA, PB, BROWB, NBUF, KOFS) do { _Pragma("unroll") for (int ks_ = 0; ks_ < 2; ++ks_) { bf16x8 af_[8], bf_[4]; \
        _Pragma("unroll") for (int ni_ = 0; ni_ < 4; ++ni_) bf_[ni_] = *(const bf16x8*)((BUF) + (ks_ ? bofs1 : bofs0) + ni_ * 2048); \
        _Pragma("unroll") for (int mi_ = 0; mi_ < 8; ++mi_) af_[mi_] = *(const bf16x8*)((BUF) + (ks_ ? aofs1 : aofs0) + mi_ * 2048); \
        if (DO_DMA) { GEMM_DMA1(PA, PB, BROWB, NBUF, KOFS, ks_ * 2); GEMM_DMA1(PA, PB, BROWB, NBUF, KOFS, ks_ * 2 + 1); } \
        __builtin_amdgcn_s_setprio(1); \
        _Pragma("unroll") for (int mi_ = 0; mi_ < 8; ++mi_) _Pragma("unroll") for (int ni_ = 0; ni_ < 4; ++ni_) \
            acc[mi_][ni_] = __builtin_amdgcn_mfma_f32_16x16x32_bf16(bf_[ni_], af_[mi_], acc[mi_][ni_], 0, 0, 0); \
        __builtin_amdgcn_s_setprio(0); \
        } } while (0)

__device__ __forceinline__ void run_gemm_list(KP p, int layer, int ph, unsigned char* smem) {
    const bool even = (layer & 1) == 0;
    GemmCnt cn; cn.c0 = 0; cn.c1 = 0; cn.c2 = 0;
    int c3 = 0;
    if (ph == 1) { cn.c0 = even ? 64 * 10 : 64 * 8; cn.c1 = even ? 2 * 64 : 4 * 64; cn.c2 = (layer == 0) ? 64 : 0; c3 = cn.c2; }
    else if (ph == 10) { cn.c0 = 64 * 22; }
    else { cn.c0 = 64 * 4; }
    cn.T = cn.c0 + cn.c1 + cn.c2 + c3;
    int t = blockIdx.x;
    if (t >= cn.T) return;
    const int ld = (ph == 12) ? 2816 : 1024;
    const int nk = ld >> 6;
    const int tid = get_tid512(), lane = tid & 63, wid = __builtin_amdgcn_readfirstlane(tid >> 6), wr = wid >> 2, wc = wid & 3;
    const int fr = lane & 15, fq = lane >> 4;
    const int dr = lane >> 3, dp = lane & 7;
    const unsigned veven = (unsigned)(dr * ld * 2 + ((dp ^ (dr >> 1)) << 4));
    const unsigned vodd  = (unsigned)(dr * ld * 2 + ((dp ^ (4 + (dr >> 1))) << 4));
    const int swz = (fr >> 1) & 7;
    const int aofs0 = (wr * 128 + fr) * 128 + (((0 + fq) ^ swz) << 4);
    const int aofs1 = (wr * 128 + fr) * 128 + (((4 + fq) ^ swz) << 4);
    const int bofs0 = 32768 + (wc * 64 + fr) * 128 + (((0 + fq) ^ swz) << 4);
    const int bofs1 = 32768 + (wc * 64 + fr) * 128 + (((4 + fq) ^ swz) << 4);
    unsigned char* buf0 = smem; unsigned char* buf1 = smem + 65536;

    GemmD d; int tm, tn;
    gemm_desc(p, layer, ph, t, cn, d, tm, tn);
    __amdgpu_buffer_rsrc_t Ag = GEMM_RSRC((const char*)d.A + (size_t)tm * 512 * ld);
    const bool gate = (ph == 10);
#define GEMM_BROW(TN) (gate ? (((wid & 1) ? 2816 : 0) + (TN) * 128 + (wid >> 1) * 32) * ld * 2 : wid * 32 * ld * 2)
    __amdgpu_buffer_rsrc_t Bg = GEMM_RSRC((const char*)d.B + (gate ? (size_t)0 : (size_t)tn * 512 * ld));
    int browb = GEMM_BROW(tn);
    __syncthreads();
    GEMM_DMA(Ag, Bg, browb, buf0, 0);
    __syncthreads();
    for (;;) {
        const int t2 = t + gridDim.x;
        const bool hasn = t2 < cn.T;
        __amdgpu_buffer_rsrc_t nAg = Ag, nBg = Bg; int nbrowb = browb;
        if (hasn) {
            GemmD dn; int ntm, ntn;
            gemm_desc(p, layer, ph, t2, cn, dn, ntm, ntn);
            nAg = GEMM_RSRC((const char*)dn.A + (size_t)ntm * 512 * ld);
            nBg = GEMM_RSRC((const char*)dn.B + (gate ? (size_t)0 : (size_t)ntn * 512 * ld));
            nbrowb = GEMM_BROW(ntn);
        }
        f32x4 acc[8][4];
#pragma unroll
        for (int i = 0; i < 8; ++i)
#pragma unroll
            for (int j = 0; j < 4; ++j) acc[i][j] = (f32x4){0.f, 0.f, 0.f, 0.f};
        for (int kt = 0; kt < nk; kt += 2) {
            const bool last = (kt + 2 >= nk);
            GEMM_STEP(buf0, 1, Ag, Bg, browb, buf1, (kt + 1) * 128);
            __syncthreads();
            {
                const bool dodma = !last || hasn;
                const __amdgpu_buffer_rsrc_t sA = last ? nAg : Ag, sB = last ? nBg : Bg;
                const int kofs = last ? 0 : (kt + 2) * 128;
                const int sbrow = last ? nbrowb : browb;
                GEMM_STEP(buf1, dodma, sA, sB, sbrow, buf0, kofs);
            }
            __syncthreads();
        }
        {
            int tl = t; asm volatile("" : "+s"(tl));
            gemm_desc(p, layer, ph, tl, cn, d, tm, tn);
        }
        __shared__ float rstab[256];
        if (d.rsmode) {
            const int tq = get_tid512();
            if (tq < 256) rstab[tq] = rss_rstd(d.rss + (size_t)(((d.rsmode == 1) ? tm : tn) * 256 + tq) * 16);
            __syncthreads();
        }
        gemm_epilogue(d, tm, tn, acc, rstab);
        if (!hasn) break;
        t = t2; Ag = nAg; Bg = nBg; browb = nbrowb;
        gemm_desc(p, layer, ph, t, cn, d, tm, tn);
    }
}

__device__ __forceinline__ void run_phase(KP p, int layer, int ph, unsigned char* smem_all) {
    const bool even = (layer & 1) == 0;
    unsigned char* ws = p->ws;
    unsigned char* smem = smem_all + vhalf() * 65536;
    switch (ph) {
    case 0: {
        const int e = layer >> 1;
        const int n_in = 16 * 48, n_out = 16 * 16, n_xq = 256, n_xkv = (layer == 0) ? 4 * 16 * 32 : 0, n_xo = 256, n_up = 16 * 88, n_dn = 44 * 16;
        const int T = n_in + n_out + n_xq + n_xkv + n_xo + n_up + n_dn;
        for (int t = vbid(); t < T; t += nvb()) {
            int u = t;
            if (u < n_in) { wconv_tile(even ? p->in[6] + (size_t)e * 1024 * 3072 : p->in[13] + (size_t)e * 1024 * 3072, (bf16_t*)(ws + WT_IN_OFF), 1024, 3072, u, smem, p->in[2] + layer * 1024); continue; }
            u -= n_in;
            if (u < n_out) { wconv_tile(even ? p->in[12] + (size_t)e * 1024 * 1024 : p->in[14] + (size_t)e * 1024 * 1024, (bf16_t*)(ws + WT_OUT_OFF), 1024, 1024, u, smem); continue; }
            u -= n_out;
            if (u < n_xq) { wconv_tile(p->in[15] + (size_t)layer * 1024 * 1024, (bf16_t*)(ws + WT_XQ_OFF), 1024, 1024, u, smem, p->in[3] + layer * 1024); continue; }
            u -= n_xq;
            if (u < n_xkv) { const int lm = u >> 9; wconv_tile(p->in[16] + (size_t)lm * 1024 * 2048, (bf16_t*)(ws + WTKV4_OFF) + (size_t)lm * 2097152, 1024, 2048, u & 511, smem); continue; }
            u -= n_xkv;
            if (u < n_xo) { wconv_tile(p->in[19] + (size_t)layer * 1024 * 1024, (bf16_t*)(ws + WT_XO_OFF), 1024, 1024, u, smem); continue; }
            u -= n_xo;
            if (u < n_up) { wconv_tile(p->in[20] + (size_t)layer * 1024 * 5632, (bf16_t*)(ws + WT_UP_OFF), 1024, 5632, u, smem, p->in[20 - 15] + layer * 1024); continue; }
            u -= n_up;
            wconv_tile(p->in[22] + (size_t)layer * 2816 * 1024, (bf16_t*)(ws + WT_DOWN_OFF), 2816, 1024, u, smem);
        }
        if (layer == 0) {
            const int lane = get_tid() & 63;
            float* rs0 = (float*)(ws + RSS_OFF);
            for (int rr = vbid() * 4 + (get_tid() >> 6); rr < NTOK; rr += nvb() * 4) {
                const f32x4* sp = (const f32x4*)(p->in[0] + (size_t)rr * 1024);
                float ss = 0.f;
#pragma unroll
                for (int i = 0; i < 4; ++i) {
                    const f32x4 v = sp[lane + 64 * i];
                    ss += v[0] * v[0] + v[1] * v[1] + v[2] * v[2] + v[3] * v[3];
                    ((f32x4*)(p->X + (size_t)rr * 1024))[lane + 64 * i] = v;
                    u32x2 o; o.x = pk_bf16(v[0], v[1]); o.y = pk_bf16(v[2], v[3]);
                    ((u32x2*)((bf16_t*)(ws + H_OFF) + (size_t)rr * 1024))[lane + 64 * i] = o;
                }
                ss = wave_sum(ss);
                if (lane < 16) rs0[(size_t)rr * 16 + lane] = (lane == 0) ? ss : 0.f;
            }
        }
        if (layer == 0) for (int lm = 0; lm < 4; ++lm) norm_rows(p->in[1], p->in[4] + lm * 1024, (bf16_t*)(ws + MH_OFF) + (size_t)lm * 1048576, nullptr, 1024);
    } break;
    case 1: case 4: case 6: case 8: case 10: case 12:
        run_gemm_list(p, layer, ph, smem_all); break;
    case 2: {
        if (even) {
            const int e2 = layer >> 1;
            float smax2;
            {
                const int ln = get_tid() & 63;
                float ga = fabsf(p->in[8][e2 * 64 + ln]), gb = fabsf(p->in[9][e2 * 64 + ln]);
#pragma unroll
                for (int o = 32; o >= 1; o >>= 1) { ga = fmaxf(ga, __shfl_xor(ga, o)); gb = fmaxf(gb, __shfl_xor(gb, o)); }
                smax2 = 0.125f * LOG2E * 64.0f * ga * gb;
            }
            const float lam_init = 0.8f - 0.6f * expf(-0.3f * (float)layer);
            float lam;
            {
                const int ln = get_tid() & 63;
                const float* lv = p->in[10] + (size_t)e2 * 256;
                float a = lv[ln] * lv[64 + ln], bq = lv[128 + ln] * lv[192 + ln];
                a = wave_sum(a); bq = wave_sum(bq);
                lam = expf(a) - expf(bq) + lam_init;
            }
            unsigned* ctr = (unsigned*)(ws + BAR_OFF) + 3600 + e2;
            __shared__ int s_unit;
            for (;;) {
                __syncthreads();
                if (threadIdx.x == 0) s_unit = (int)__hip_atomic_fetch_add(ctr, 1u, __ATOMIC_RELAXED, __HIP_MEMORY_SCOPE_AGENT);
                __syncthreads();
                const int u = s_unit;
                if (u >= 512) break;
                const int qi = 31 - (u >> 4), b = (u >> 2) & 3, head = u & 3, br = vhalf();
                const float slope2 = exp2f(-2.0f * (float)(head + 1)) * LOG2E;
                const float Df = (160.0f + 2.0f * smax2) / slope2;
                int cmin = 0;
                if (Df < 8192.0f) { const int a = qi * 128 - 63 - ((int)Df + 1); cmin = a > 0 ? (a + 63) >> 6 : 0; }
                diff_attn_unit(p, b, head, br, qi, cmin, smem, smem_all + 65536, lam, p->in[11] + (size_t)e2 * 128, 1.0f - lam_init);
            }
            for (int u = vbid(); u < 512; u += nvb()) ya_unit(p, layer >> 1, u);
        } else {
            for (int j = blockIdx.x; j < 1024; j += gridDim.x) {
                const int bhp = j >> 5, i = j & 31;
                sb_attn_unit(p, bhp >> 3, (bhp & 7) * 2 + vhalf(), 31 - i, smem, (volatile int*)(smem_all + 32768));
            }
        }
        knorm_rows(p, layer, vbid() * 4 + (get_tid() >> 6), nvb() * 4);
    } break;
    case 3: if (even) combine_rows(p, layer, layer >> 1); break;
    case 7: {
        int j0 = vbid(), jstep = nvb();
        if ((int)gridDim.x >= 256) {
            const int t = (int)blockIdx.x, v = (t & 7) * 32 + (t >> 3);
            const int tm = v >> 2, tn = v & 3;
            j0 = (t < 256) ? ((((tm >> 4) * 4 + tn) << 5) | ((tm & 15) * 2 + vhalf())) : 512;
            jstep = 1 << 20;
        }
        for (int j = j0; j < 512; j += jstep) {
            const int bh = j >> 5, i = j & 31;
            cross_attn_unit(p, layer, bh >> 2, bh & 3, i, smem);
        }
    } break;
    case 11: ffn_gate(p, layer); break;
    }
}

__global__ void __launch_bounds__(512, 2) mega(Params p_arg, int ph_begin, int ph_end, int coop) {
    __shared__ __attribute__((aligned(16))) unsigned char smem[131072];
    __shared__ uint4 xb_words;
    cg::grid_group grid = cg::this_grid();
    KP p = (KP)__builtin_amdgcn_kernarg_segment_ptr();
    if (p->ws == nullptr) grid.sync();
    XcdBarrier xb;
    if (coop) {
        if (threadIdx.x == 0) xb_words = make_uint4(0u, 0u, 0u, 0u);
        __syncthreads();
        xb = xcd_barrier_post((unsigned*)(p->ws + BAR_OFF), (volatile LAS unsigned*)&xb_words);
    }
    for (int gp = ph_begin; gp < ph_end; ++gp) {
        const int layer = gp / NPH, ph = gp % NPH;
        if (ph == 3) continue;
        if (ph == 5 || ph == 9) continue;
        asm volatile("" : "+s"(p));
        run_phase(p, layer, ph, smem);
        if (coop && gp + 1 < ph_end) {
            if (ph == 6 && (int)gridDim.x >= 256) { asm volatile("s_waitcnt vmcnt(0)" ::: "memory"); __syncthreads(); }
            else xcd_barrier(xb);
        }
    }
}

__global__ void dbg_sanitize(float* X, int n) {
    for (int i = blockIdx.x * 256 + threadIdx.x; i < n; i += gridDim.x * 256) { float v = X[i]; if (!(fabsf(v) < 1e30f)) X[i] = 12345.0f; }
}
extern "C" void kernel_launch(void* const* d_in, const int* in_sizes, int n_in, void* d_out, int out_size, void* d_ws, size_t ws_size,
                              hipStream_t stream) {
    static int grid_blocks = 0;
    if (!grid_blocks) {
        int dev = 0, cus = 0, per_cu = 0;
        hipGetDevice(&dev);
        hipDeviceGetAttribute(&cus, hipDeviceAttributeMultiprocessorCount, dev);
        hipOccupancyMaxActiveBlocksPerMultiprocessor(&per_cu, mega, 512, 0);
        if (per_cu > 1) per_cu = 1;
        if (per_cu < 1) per_cu = 1;
        grid_blocks = cus * per_cu;
    }
    if (ws_size < (size_t)WS_NEED) return;
    Params p{};
    for (int i = 0; i < 23; ++i) p.in[i] = (const float*)d_in[i];
    p.X = (float*)d_out;
    p.ws = (unsigned char*)d_ws;
#ifndef MULTI_LAUNCH
#define MULTI_LAUNCH 0
#endif
#ifndef DBG_END
#define DBG_END 52
#endif
#if MULTI_LAUNCH
    for (int g = 0; g < DBG_END; ++g) {
        if ((g % NPH) == 3) continue;
        if ((g % NPH) == 5 || (g % NPH) == 9) continue;
        hipLaunchKernelGGL(mega, dim3(grid_blocks), dim3(512), 0, stream, p, g, g + 1, 0);
    }
#else
    hipMemsetAsync((unsigned char*)d_ws + BAR_OFF, 0, 16384, stream);
    int b = 0, e = 4 * NPH, coop = 1;
    void* args[] = {&p, &b, &e, &coop};
    hipError_t err = hipLaunchCooperativeKernel((void*)mega, dim3(grid_blocks), dim3(512), args, 0, stream);
    if (err != hipSuccess) fprintf(stderr, "cooperative launch failed: %s (grid %d)\n", hipGetErrorString(err), grid_blocks);
#endif
}
```

```cpp
#include <hip/hip_runtime.h>
#include <hip/hip_cooperative_groups.h>
#include <cstdio>
#include <cstdint>
namespace cg = cooperative_groups;

typedef unsigned short bf16_t;
typedef short bf16x8 __attribute__((ext_vector_type(8)));
typedef float f32x4 __attribute__((ext_vector_type(4)));
typedef float f32x16 __attribute__((ext_vector_type(16)));
typedef unsigned u32x4 __attribute__((ext_vector_type(4)));
typedef unsigned u32x2 __attribute__((ext_vector_type(2)));

#define SEQ 4096
#define DM 1024
#define NTOK 16384
#define DFF 2816
#define LOG2E 1.4426950408889634f

#define WT_IN_OFF   0ull
#define WT_OUT_OFF  (WT_IN_OFF + 3072ull * 1024 * 2)
#define WT_XQ_OFF   (WT_OUT_OFF + 1024ull * 1024 * 2)
#define WT_XKV_OFF  (WT_XQ_OFF + 1024ull * 1024 * 2)
#define WT_XO_OFF   (WT_XKV_OFF + 2048ull * 1024 * 2)
#define WT_UP_OFF   (WT_XO_OFF + 1024ull * 1024 * 2)
#define WT_DOWN_OFF (WT_UP_OFF + 5632ull * 1024 * 2)
#define H_OFF       (WT_DOWN_OFF + 1024ull * 2816 * 2)
#define MH_OFF      (H_OFF + 16384ull * 1024 * 2)
#define KM_OFF      (MH_OFF + 4 * 1024ull * 1024 * 2)
#define VTM_OFF     (KM_OFF + 4 * 1024ull * 1024 * 2)
#define WTKV4_OFF   (VTM_OFF + 4 * 1024ull * 1024 * 2)
#define R_OFF       (WTKV4_OFF + 4 * 2048ull * 1024 * 2)
#define MiB (1024ull * 1024)
#define P_OFF       (R_OFF)
#define VT_OFF      (R_OFF + 80 * MiB)
#define Y_OFF       (R_OFF + 112 * MiB)
#define O12_OFF     (R_OFF + 144 * MiB)
#define QX_OFF      (R_OFF)
#define YX_OFF      (R_OFF + 32 * MiB)
#define U_OFF       (R_OFF)
#define G_OFF       (R_OFF + 16 * MiB)
#define US_OFF      (R_OFF)
#define BAR_OFF     (R_OFF + 176 * MiB)
#define RSS_OFF     (BAR_OFF + 16384)
#define RSS_SLOT    (16384 * 16)
#define WS_NEED     (RSS_OFF + 13ull * RSS_SLOT * 4 + 4096)

struct Params {
    const float* in[23];
    float* X;
    unsigned char* ws;
};
typedef const __attribute__((address_space(4))) Params* KP;

typedef __bf16 bf16x2_t __attribute__((ext_vector_type(2)));
typedef float f32x2 __attribute__((ext_vector_type(2)));
__device__ __forceinline__ unsigned pk_bf16(float lo, float hi) {
    f32x2 v = {lo, hi};
    bf16x2_t b = __builtin_convertvector(v, bf16x2_t);
    return __builtin_bit_cast(unsigned, b);
}
__device__ __forceinline__ float bf_lo(unsigned w) { return __uint_as_float(w << 16); }
__device__ __forceinline__ float bf_hi(unsigned w) { return __uint_as_float(w & 0xffff0000u); }
__device__ __forceinline__ float wave_sum(float v) {
#pragma unroll
    for (int o = 32; o >= 1; o >>= 1) v += __shfl_xor(v, o);
    return v;
}
__device__ __forceinline__ int get_tid() { int t = threadIdx.x & 255; asm volatile("" : "+v"(t)); return t; }
__device__ __forceinline__ int get_tid512() { int t = threadIdx.x; asm volatile("" : "+v"(t)); return t; }
__device__ __forceinline__ int vhalf() { return __builtin_amdgcn_readfirstlane((int)(threadIdx.x >> 8)); }
__device__ __forceinline__ int vbid() { return (int)blockIdx.x * 2 + vhalf(); }
__device__ __forceinline__ int nvb() { return (int)gridDim.x * 2; }
__device__ __forceinline__ float dpp_ror1(float x) { return __int_as_float(__builtin_amdgcn_update_dpp(0, __float_as_int(x), 0x121, 0xf, 0xf, false)); }
__device__ __forceinline__ float dpp_ror2(float x) { return __int_as_float(__builtin_amdgcn_update_dpp(0, __float_as_int(x), 0x122, 0xf, 0xf, false)); }
__device__ __forceinline__ float fexp2(float x) { return __builtin_amdgcn_exp2f(x); }
__device__ __forceinline__ float flog2(float x) { return __builtin_amdgcn_logf(x); }

struct GemmD {
    const bf16_t* A; const bf16_t* B; int lda, ldb, K, MT, NT;
    int mode;
    void* C; int ldc; int colblk; long cbstride;
    const float* g0; const float* g1; int nq0, nq1, nsc0, nsplit; float qscale; float* aux;
    const float* rss; int rsmode;
};

__device__ __forceinline__ float rss_rstd(const float* q) {
    const f32x4 a = *(const f32x4*)q, b = *(const f32x4*)(q + 4), c = *(const f32x4*)(q + 8), e = *(const f32x4*)(q + 12);
    const f32x4 t = (a + b) + (c + e);
    return rsqrtf(((t[0] + t[1]) + (t[2] + t[3])) * (1.0f / 1024.0f) + 1e-6f);
}
__device__ __forceinline__ void gemm_epilogue(const GemmD& d, int tm, int tn, f32x4 (&acc)[8][4], const float* rstab) {
    const int tid = get_tid512(), lane = tid & 63, wid = __builtin_amdgcn_readfirstlane(tid >> 6), wr = wid >> 2, wc = wid & 3;
    const int fr = lane & 15, fq = lane >> 4;
    const int row0 = tm * 256 + wr * 128 + fr;
    const int colw = tn * 256 + wc * 64;
    if (d.mode == 1) {
        float* X = (float*)d.C; bf16_t* XB = (bf16_t*)d.g1; float* rso = d.aux;
#pragma unroll
        for (int mi = 0; mi < 8; ++mi) {
            float ss = 0.f;
#pragma unroll
            for (int ni = 0; ni < 4; ++ni) {
                const size_t off = (size_t)(row0 + mi * 16) * 1024 + colw + ni * 16 + fq * 4;
                f32x4 v = *(f32x4*)(X + off); v += acc[mi][ni]; *(f32x4*)(X + off) = v;
                ss += v[0] * v[0] + v[1] * v[1] + v[2] * v[2] + v[3] * v[3];
                u32x2 w; w.x = pk_bf16(v[0], v[1]); w.y = pk_bf16(v[2], v[3]);
                *(u32x2*)(XB + off) = w;
            }
            ss += __shfl_xor(ss, 16); ss += __shfl_xor(ss, 32);
            if (fq == 0) rso[(size_t)(row0 + mi * 16) * 16 + tn * 4 + wc] = ss;
            if (mi & 1) __builtin_amdgcn_sched_barrier(0);
        }
        return;
    }
    const float* rs = d.rss;
    const int rsmode = d.rsmode;
#define ROWF(mi_) ((rsmode == 1) ? rstab[wr * 128 + (mi_) * 16 + fr] : 1.0f)
    if (d.mode == 4) {
        const float* cw = d.g0; float* Us = d.aux; bf16_t* G = (bf16_t*)d.C;
        const int gb = tm * 2 + wr;
#pragma unroll
        for (int nh = 0; nh < 2; ++nh) {
            const int ch = tn * 128 + wc * 32 + nh * 16 + fq * 4;
            const f32x4 wg0 = *(const f32x4*)(cw + ch), wg1 = *(const f32x4*)(cw + 5632 + ch), wg2 = *(const f32x4*)(cw + 11264 + ch);
            const f32x4 wv0 = *(const f32x4*)(cw + 2816 + ch), wv1 = *(const f32x4*)(cw + 5632 + 2816 + ch), wv2 = *(const f32x4*)(cw + 11264 + 2816 + ch);
            if (fr < 2) { const int uo = (gb * 4 + fr) * 5632 + ch; const float rf0 = ROWF(0); *(f32x4*)(Us + uo) = acc[0][nh] * rf0; *(f32x4*)(Us + uo + 2816) = acc[0][nh + 2] * rf0; }
            if (fr >= 14) { const int uo = (gb * 4 + fr - 12) * 5632 + ch; const float rf7 = ROWF(7); *(f32x4*)(Us + uo) = acc[7][nh] * rf7; *(f32x4*)(Us + uo + 2816) = acc[7][nh + 2] * rf7; }
            f32x4 pg1 = {0.f, 0.f, 0.f, 0.f}, pg2 = pg1, pv1 = pg1, pv2 = pg1;
#pragma unroll
            for (int mi = 0; mi < 8; ++mi) {
                const float rf = ROWF(mi);
                const f32x4 g0 = acc[mi][nh] * rf, v0 = acc[mi][nh + 2] * rf;
                f32x4 rg1, rg2, rv1, rv2;
#pragma unroll
                for (int e = 0; e < 4; ++e) { rg1[e] = dpp_ror1(g0[e]); rg2[e] = dpp_ror2(g0[e]); rv1[e] = dpp_ror1(v0[e]); rv2[e] = dpp_ror2(v0[e]); }
                const f32x4 g1 = (fr == 0) ? pg1 : rg1, g2 = (fr < 2) ? pg2 : rg2;
                const f32x4 v1 = (fr == 0) ? pv1 : rv1, v2 = (fr < 2) ? pv2 : rv2;
                const f32x4 cg = wg2 * g0 + wg1 * g1 + wg0 * g2;
                const f32x4 cv = wv2 * v0 + wv1 * v1 + wv0 * v2;
                f32x4 o;
#pragma unroll
                for (int e = 0; e < 4; ++e) o[e] = cg[e] * __builtin_amdgcn_rcpf(1.0f + fexp2(-LOG2E * cg[e])) * cv[e];
                u32x2 w; w.x = pk_bf16(o[0], o[1]); w.y = pk_bf16(o[2], o[3]);
                *(u32x2*)(G + ((row0 + mi * 16) * 2816 + ch)) = w;
                pg1 = rg1; pg2 = rg2; pv1 = rv1; pv2 = rv2;
            }
            __builtin_amdgcn_sched_barrier(0);
        }
        return;
    }
    {
        f32x4 colf[4];
#pragma unroll
        for (int ni = 0; ni < 4; ++ni)
#pragma unroll
            for (int e = 0; e < 4; ++e) colf[ni][e] = (rsmode == 2) ? rstab[wc * 64 + ni * 16 + fq * 4 + e] : 1.0f;
        const bool donorm = (d.mode == 2) && (colw >= d.nq0) && (colw < d.nq1);
        const bool doscale = (d.mode == 2) && (colw >= d.nsc0) && (colw < d.nsplit);
        const float* g = (colw < d.nsplit) ? d.g0 : d.g1;
        const float sc = doscale ? d.qscale : 1.0f;
        bf16_t* C = (bf16_t*)d.C;
        int cb = 0; if (d.colblk) cb = colw / d.colblk;
        bf16_t* base = C + (size_t)cb * d.cbstride + (colw - cb * d.colblk);
#pragma unroll
        for (int mi = 0; mi < 8; ++mi) {
            f32x4 v[4];
            {
                const float rf = ROWF(mi);
#pragma unroll
                for (int ni = 0; ni < 4; ++ni) v[ni] = acc[mi][ni] * colf[ni] * rf;
            }
            if (donorm) {
                float ss = 0.f;
#pragma unroll
                for (int ni = 0; ni < 4; ++ni) ss += v[ni][0] * v[ni][0] + v[ni][1] * v[ni][1] + v[ni][2] * v[ni][2] + v[ni][3] * v[ni][3];
                ss += __shfl_xor(ss, 16); ss += __shfl_xor(ss, 32);
                const float rstd = rsqrtf(ss * (1.0f / 64.0f) + 1e-6f);
#pragma unroll
                for (int ni = 0; ni < 4; ++ni) { const f32x4 gv = *(const f32x4*)(g + ni * 16 + fq * 4); v[ni] = v[ni] * gv * rstd; }
            }
#pragma unroll
            for (int ni = 0; ni < 4; ++ni) {
                const f32x4 o = v[ni] * sc;
                u32x2 w; w.x = pk_bf16(o[0], o[1]); w.y = pk_bf16(o[2], o[3]);
                *(u32x2*)(base + (size_t)(row0 + mi * 16) * d.ldc + ni * 16 + fq * 4) = w;
            }
            __builtin_amdgcn_sched_barrier(0);
        }
    }
}

__device__ __forceinline__ void tile_map(int u, int MT, int NT, int& tm, int& tn) {
    const int GH = MT < 1 ? MT : 1;
    const int per = GH * NT;
    const int grp = u / per, r = u - grp * per;
    tm = grp * GH + (r % GH); tn = r / GH;
}

#define MFMA32(a, b, c) __builtin_amdgcn_mfma_f32_32x32x16_bf16((a), (b), (c), 0, 0, 0)

__device__ __forceinline__ void k64_load(u32x4 (&r)[2], const bf16_t* g, int ld) {
    const int tid = get_tid(), row = tid >> 3, ch = tid & 7;
#pragma unroll
    for (int i = 0; i < 2; ++i) r[i] = *(const u32x4*)(g + (size_t)(row + 32 * i) * ld + ch * 8);
}
__device__ __forceinline__ void k64_store(const u32x4 (&r)[2], unsigned char* lds) {
    const int tid = get_tid(), row = tid >> 3, ch = tid & 7;
    const int ofs = row * 128 + ((ch ^ ((row >> 1) & 7)) << 4);
#pragma unroll
    for (int i = 0; i < 2; ++i) *(u32x4*)(lds + ofs + i * 4096) = r[i];
}
template <int NP>
__device__ __forceinline__ void vt_load(u32x4 (&r)[NP], const bf16_t* g, size_t ld) {
    const int tid = get_tid(), row = tid >> 3, ch = tid & 7;
#pragma unroll
    for (int i = 0; i < NP; ++i) r[i] = *(const u32x4*)(g + (size_t)(row + 32 * i) * ld + ch * 8);
}
template <int NP>
__device__ __forceinline__ void vt_store(const u32x4 (&r)[NP], unsigned char* lds) {
    const int tid = get_tid(), row = tid >> 3, ch = tid & 7;
    const int ofs = row * 128 + ((ch ^ ((row >> 1) & 7)) << 4);
    const bool sw = (row >> 4) & 1;
#pragma unroll
    for (int i = 0; i < NP; ++i) {
        u32x4 v = r[i];
        if (sw) v = (u32x4){v.z, v.w, v.x, v.y};
        *(u32x4*)(lds + ofs + i * 4096) = v;
    }
}
__device__ __forceinline__ bf16x8 vt_frag(const unsigned char* lds, int mt, int kt, int s, int lane) {
    const int r = lane & 31, h = lane >> 5;
    const int row = mt * 32 + r;
    const int sw = (r >> 1) & 7, g = h ^ ((r >> 4) & 1);
    const int c1 = kt * 4 + 2 * s;
    const u32x2 lo = *(const u32x2*)(lds + row * 128 + (((c1) ^ sw) << 4) + g * 8);
    const u32x2 hi = *(const u32x2*)(lds + row * 128 + (((c1 + 1) ^ sw) << 4) + g * 8);
    u32x4 v = (u32x4){lo.x, lo.y, hi.x, hi.y};
    return __builtin_bit_cast(bf16x8, v);
}
__device__ __forceinline__ bf16x8 pack8(const f32x16& p, int s) {
    u32x4 v;
    if (s == 0) { v.x = pk_bf16(p[0], p[1]); v.y = pk_bf16(p[2], p[3]); v.z = pk_bf16(p[4], p[5]); v.w = pk_bf16(p[6], p[7]); }
    else        { v.x = pk_bf16(p[8], p[9]); v.y = pk_bf16(p[10], p[11]); v.z = pk_bf16(p[12], p[13]); v.w = pk_bf16(p[14], p[15]); }
    return __builtin_bit_cast(bf16x8, v);
}
__device__ __forceinline__ bf16x8 k64_frag(const unsigned char* lds, int kt, int ks, int lane) {
    const int r = lane & 31, h = lane >> 5;
    const int row = kt * 32 + r;
    return *(const bf16x8*)(lds + row * 128 + (((ks * 2 + h) ^ ((r >> 1) & 7)) << 4));
}

__device__ __forceinline__ void diff_attn_unit(KP p, int b, int head, int br, int qi, int cmin, unsigned char* smem, unsigned char* xch_lds, float lam, const float* subln, float osc) {
    const int tid = get_tid(), lane = tid & 63, w = tid >> 6, r = lane & 31, h = lane >> 5;
    const bf16_t* P = (const bf16_t*)(p->ws + P_OFF);
    const bf16_t* VT = (const bf16_t*)(p->ws + VT_OFF) + ((size_t)b * 512 + head * 128) * SEQ;
    const bf16_t* Pq = P + (size_t)(b * SEQ) * 2560 + 1536 + head * 128 + br * 64;
    const bf16_t* Pk = P + (size_t)(b * SEQ) * 2560 + 2048 + head * 128 + br * 64;
    const int q0w = qi * 128 + w * 32;
    const int qpos = q0w + r;
    const float slope2 = exp2f(-2.0f * (float)(head + 1)) * LOG2E;
    bf16x8 qext, kext[2];
    {
        const unsigned hi = pk_bf16(slope2, 0.f) & 0xffffu;
        const float hif = __uint_as_float(hi << 16);
        const unsigned lo = pk_bf16(slope2 - hif, 0.f) & 0xffffu;
        u32x4 qe = {h == 0 ? (hi | (lo << 16)) : 0u, 0u, 0u, 0u};
        qext = __builtin_bit_cast(bf16x8, qe);
#pragma unroll
        for (int kt = 0; kt < 2; ++kt) {
            const float rf = (float)(kt * 32 + r);
            u32x4 ke = {h == 0 ? pk_bf16(rf, rf) : 0u, 0u, 0u, 0u};
            kext[kt] = __builtin_bit_cast(bf16x8, ke);
        }
    }
    bf16x8 qf[4];
#pragma unroll
    for (int ks = 0; ks < 4; ++ks) qf[ks] = *(const bf16x8*)(Pq + (size_t)qpos * 2560 + ks * 16 + h * 8);
    f32x16 O[4];
#pragma unroll
    for (int mt = 0; mt < 4; ++mt)
#pragma unroll
        for (int i = 0; i < 16; ++i) O[mt][i] = 0.f;
    float m = -1e30f, l = 0.f;
    unsigned char* ldsK = smem; unsigned char* ldsV = smem + 8192;
    u32x4 rk[2], rv[4];
    int c = 2 * qi + 1;
    k64_load(rk, Pk + (size_t)(c * 64) * 2560, 2560);
    vt_load<4>(rv, VT + c * 64, SEQ);
    for (; c >= cmin; --c) {
        __syncthreads();
        k64_store(rk, ldsK); vt_store<4>(rv, ldsV);
        __syncthreads();
        if (c > cmin) { k64_load(rk, Pk + (size_t)((c - 1) * 64) * 2560, 2560); vt_load<4>(rv, VT + (c - 1) * 64, SEQ); }
        const int key0 = c * 64;
        if (key0 > q0w + 31) continue;
        f32x16 S[2];
#pragma unroll
        for (int kt = 0; kt < 2; ++kt) {
#pragma unroll
            for (int i = 0; i < 16; ++i) S[kt][i] = 0.f;
#pragma unroll
            for (int ks = 0; ks < 4; ++ks) S[kt] = MFMA32(k64_frag(ldsK, kt, ks, lane), qf[ks], S[kt]);
            S[kt] = MFMA32(kext[kt], qext, S[kt]);
        }
        const float bc = slope2 * (float)(key0 - q0w);
        if (key0 + 63 > q0w) {
#pragma unroll
            for (int kt = 0; kt < 2; ++kt)
#pragma unroll
                for (int i = 0; i < 16; ++i) {
                    const int key = key0 + kt * 32 + 8 * (i >> 2) + 4 * h + (i & 3);
                    if (qpos - key < 0) S[kt][i] = -INFINITY;
                }
        }
        float mx;
        {
            float m0 = -1e30f, m1 = -1e30f, m2 = -1e30f, m3 = -1e30f;
#pragma unroll
            for (int kt = 0; kt < 2; ++kt)
#pragma unroll
                for (int i = 0; i < 16; i += 4) { m0 = fmaxf(m0, S[kt][i]); m1 = fmaxf(m1, S[kt][i + 1]); m2 = fmaxf(m2, S[kt][i + 2]); m3 = fmaxf(m3, S[kt][i + 3]); }
            mx = fmaxf(fmaxf(m0, m1), fmaxf(m2, m3));
        }
        mx = fmaxf(mx, __shfl_xor(mx, 32));
        const float mn = fmaxf(m, mx + bc);
        const float alpha = fexp2(m - mn);
        m = mn;
        const float mo = mn - bc;
        float ls;
        {
            float l0 = 0.f, l1 = 0.f, l2 = 0.f, l3 = 0.f;
#pragma unroll
            for (int kt = 0; kt < 2; ++kt)
#pragma unroll
                for (int i = 0; i < 16; i += 4) {
                    const float p0 = fexp2(S[kt][i] - mo), p1 = fexp2(S[kt][i + 1] - mo), p2 = fexp2(S[kt][i + 2] - mo), p3 = fexp2(S[kt][i + 3] - mo);
                    S[kt][i] = p0; S[kt][i + 1] = p1; S[kt][i + 2] = p2; S[kt][i + 3] = p3;
                    l0 += p0; l1 += p1; l2 += p2; l3 += p3;
                }
            ls = (l0 + l1) + (l2 + l3);
        }
        l = l * alpha + ls;
#pragma unroll
        for (int mt = 0; mt < 4; ++mt)
#pragma unroll
            for (int i = 0; i < 16; ++i) O[mt][i] *= alpha;
#pragma unroll
        for (int kt = 0; kt < 2; ++kt)
#pragma unroll
            for (int s = 0; s < 2; ++s) {
                const bf16x8 pb = pack8(S[kt], s);
#pragma unroll
                for (int mt = 0; mt < 4; ++mt) O[mt] = MFMA32(vt_frag(ldsV, mt, kt, s, lane), pb, O[mt]);
            }
    }
    l += __shfl_xor(l, 32);
    const float inv = 1.0f / l;
    u32x4* xch = (u32x4*)xch_lds;
    __syncthreads();
    if (br == 1) {
#pragma unroll
        for (int mt = 0; mt < 4; ++mt)
#pragma unroll
            for (int g = 0; g < 4; ++g) {
                const f32x4 o = {O[mt][4 * g] * inv, O[mt][4 * g + 1] * inv, O[mt][4 * g + 2] * inv, O[mt][4 * g + 3] * inv};
                xch[(mt * 4 + g) * 256 + tid] = __builtin_bit_cast(u32x4, o);
            }
    }
    __syncthreads();
    if (br == 0) {
        float ss = 0.f;
#pragma unroll
        for (int mt = 0; mt < 4; ++mt)
#pragma unroll
            for (int g = 0; g < 4; ++g) {
                const f32x4 o2 = __builtin_bit_cast(f32x4, xch[(mt * 4 + g) * 256 + tid]);
#pragma unroll
                for (int e = 0; e < 4; ++e) { const float t = O[mt][4 * g + e] * inv - lam * o2[e]; ss += t * t; }
            }
        ss += __shfl_xor(ss, 32);
        const float rstd = rsqrtf(ss * (1.0f / 128.0f) + 1e-6f) * osc;
        bf16_t* yp = (bf16_t*)(p->ws + Y_OFF) + (size_t)(b * SEQ + qpos) * 1024 + 512 + head * 128 + 4 * h;
#pragma unroll
        for (int mt = 0; mt < 4; ++mt)
#pragma unroll
            for (int g = 0; g < 4; ++g) {
                const f32x4 o2 = __builtin_bit_cast(f32x4, xch[(mt * 4 + g) * 256 + tid]);
                const f32x4 sg = *(const f32x4*)(subln + mt * 32 + 8 * g + 4 * h);
                f32x4 t;
#pragma unroll
                for (int e = 0; e < 4; ++e) t[e] = (O[mt][4 * g + e] * inv - lam * o2[e]) * sg[e] * rstd;
                u32x2 wv; wv.x = pk_bf16(t[0], t[1]); wv.y = pk_bf16(t[2], t[3]);
                *(u32x2*)(yp + mt * 32 + 8 * g) = wv;
            }
    }
}

__device__ __forceinline__ void sb_attn_unit(KP p, int b, int head, int qi, unsigned char* smem, volatile int* flags) {
    const int tid = get_tid(), lane = tid & 63, w = tid >> 6, r = lane & 31, h = lane >> 5;
    const bf16_t* P = (const bf16_t*)(p->ws + P_OFF);
    const bf16_t* VT = (const bf16_t*)(p->ws + VT_OFF) + ((size_t)b * 1024 + head * 64) * SEQ;
    bf16_t* Y = (bf16_t*)(p->ws + Y_OFF);
    const bf16_t* Pq = P + (size_t)(b * SEQ) * 2048 + head * 64;
    const bf16_t* Pk = P + (size_t)(b * SEQ) * 2048 + 1024 + head * 64;
    const int q0w = qi * 128 + w * 32;
    const int qpos = q0w + r;
    bf16x8 qf[4];
#pragma unroll
    for (int ks = 0; ks < 4; ++ks) qf[ks] = *(const bf16x8*)(Pq + (size_t)qpos * 2048 + ks * 16 + h * 8);
    f32x16 O[2];
#pragma unroll
    for (int mt = 0; mt < 2; ++mt)
#pragma unroll
        for (int i = 0; i < 16; ++i) O[mt][i] = 0.f;
    float carry = 0.f;
    unsigned char* ldsK = smem; unsigned char* ldsV = smem + 8192;
    u32x4 rk[2], rv[2];
    int c = 2 * qi + 1;
    k64_load(rk, Pk + (size_t)(c * 64) * 2048, 2048);
    vt_load<2>(rv, VT + c * 64, SEQ);
    int done = 0;
    const int w8 = w + 4 * vhalf();
    for (; c >= 0; --c) {
        const int wd = __all(done);
        if (lane == 0) flags[w8] = wd;
        __syncthreads();
        if (flags[0] & flags[1] & flags[2] & flags[3] & flags[4] & flags[5] & flags[6] & flags[7]) break;
        k64_store(rk, ldsK); vt_store<2>(rv, ldsV);
        __syncthreads();
        if (c > 0) { k64_load(rk, Pk + (size_t)((c - 1) * 64) * 2048, 2048); vt_load<2>(rv, VT + (c - 1) * 64, SEQ); }
        const int key0 = c * 64;
        if (key0 > q0w + 31) continue;
        f32x16 S[2];
#pragma unroll
        for (int kt = 0; kt < 2; ++kt) {
#pragma unroll
            for (int i = 0; i < 16; ++i) S[kt][i] = 0.f;
#pragma unroll
            for (int ks = 0; ks < 4; ++ks) S[kt] = MFMA32(k64_frag(ldsK, kt, ks, lane), qf[ks], S[kt]);
        }
        const int lim = qpos - key0 - 4 * h;
        f32x16 LB[2];
        float run[8];
#pragma unroll
        for (int kt = 0; kt < 2; ++kt)
#pragma unroll
            for (int g = 0; g < 4; ++g) {
                float rs = 0.f;
#pragma unroll
                for (int e = 0; e < 4; ++e) {
                    const int i = 4 * g + e;
                    const float z2 = S[kt][i] * LOG2E;
                    const float t = flog2(1.0f + fexp2(-fabsf(z2)));
                    const float lb = fminf(z2, 0.f) - t;
                    float l1 = lb - z2;
                    const bool valid = (kt * 32 + 8 * g + e) < lim;
                    if (!valid) l1 = 0.f;
                    LB[kt][i] = valid ? lb : -INFINITY;
                    S[kt][i] = l1;
                    rs += l1;
                }
                run[kt * 4 + g] = rs;
            }
        float oth[8], tot[8];
#pragma unroll
        for (int G = 0; G < 8; ++G) { oth[G] = __shfl_xor(run[G], 32); tot[G] = run[G] + oth[G]; }
        float suf = carry;
#pragma unroll
        for (int G = 7; G >= 0; --G) {
            const int kt = G >> 2, g = G & 3;
            float tail = suf + (h == 0 ? oth[G] : 0.f);
#pragma unroll
            for (int e = 3; e >= 0; --e) {
                const int i = 4 * g + e;
                const float l1 = S[kt][i];
                S[kt][i] = fexp2(LB[kt][i] + tail);
                tail += l1;
            }
            suf += tot[G];
        }
        carry = suf;
#pragma unroll
        for (int kt = 0; kt < 2; ++kt)
#pragma unroll
            for (int s = 0; s < 2; ++s) {
                const bf16x8 pb = pack8(S[kt], s);
#pragma unroll
                for (int mt = 0; mt < 2; ++mt) O[mt] = MFMA32(vt_frag(ldsV, mt, kt, s, lane), pb, O[mt]);
            }
        done = (carry < -151.0f);
    }
    __syncthreads();
    bf16_t* op = Y + (size_t)(b * SEQ + qpos) * 1024 + head * 64;
#pragma unroll
    for (int mt = 0; mt < 2; ++mt)
#pragma unroll
        for (int g = 0; g < 4; ++g) {
            u32x2 wv; wv.x = pk_bf16(O[mt][4 * g], O[mt][4 * g + 1]); wv.y = pk_bf16(O[mt][4 * g + 2], O[mt][4 * g + 3]);
            *(u32x2*)(op + mt * 32 + 8 * g + 4 * h) = wv;
        }
}

__device__ __forceinline__ bf16x8 k256_frag(const unsigned char* lds, int kt, int ks, int lane) {
    const int r = lane & 31, h = lane >> 5;
    const int row = kt * 32 + r;
    const int ch = ks * 2 + h;
    return *(const bf16x8*)(lds + row * 512 + ((((ch & 15) ^ (row & 15)) | (ch & 16)) << 4));
}
__device__ __forceinline__ void cross_attn_unit(KP p, int layer, int b, int head, int qi, unsigned char* smem) {
    const int tid = get_tid(), lane = tid & 63, w = tid >> 6, r = lane & 31, h = lane >> 5;
    const bf16_t* Qx = (const bf16_t*)(p->ws + QX_OFF);
    const bf16_t* Km = (const bf16_t*)(p->ws + KM_OFF) + (size_t)layer * 1048576 + (size_t)(b * 256) * 1024 + head * 256;
    const bf16_t* VT = (const bf16_t*)(p->ws + VTM_OFF) + (size_t)layer * 1048576 + ((size_t)b * 1024 + head * 256) * 256;
    bf16_t* Yx = (bf16_t*)(p->ws + YX_OFF);
    const float* qg = p->in[17] + layer * 256;
    const int qpos = qi * 128 + w * 32 + r;
    const bf16_t* qrow = Qx + (size_t)(b * SEQ + qpos) * 1024 + head * 256;
    bf16x8 qf[16];
    {
        float ss = 0.f;
#pragma unroll
        for (int ks = 0; ks < 16; ++ks) {
            const u32x4 v = *(const u32x4*)(qrow + ks * 16 + h * 8);
            qf[ks] = __builtin_bit_cast(bf16x8, v);
            ss += bf_lo(v.x) * bf_lo(v.x) + bf_hi(v.x) * bf_hi(v.x) + bf_lo(v.y) * bf_lo(v.y) + bf_hi(v.y) * bf_hi(v.y)
                + bf_lo(v.z) * bf_lo(v.z) + bf_hi(v.z) * bf_hi(v.z) + bf_lo(v.w) * bf_lo(v.w) + bf_hi(v.w) * bf_hi(v.w);
        }
        ss += __shfl_xor(ss, 32);
        const float sc = rsqrtf(ss * (1.0f / 256.0f) + 1e-6f) * (0.0625f * LOG2E);
#pragma unroll
        for (int ks = 0; ks < 16; ++ks) {
            const u32x4 v = __builtin_bit_cast(u32x4, qf[ks]);
            const f32x4 ga = *(const f32x4*)(qg + ks * 16 + h * 8), gb = *(const f32x4*)(qg + ks * 16 + h * 8 + 4);
            u32x4 o;
            o.x = pk_bf16(bf_lo(v.x) * ga[0] * sc, bf_hi(v.x) * ga[1] * sc);
            o.y = pk_bf16(bf_lo(v.y) * ga[2] * sc, bf_hi(v.y) * ga[3] * sc);
            o.z = pk_bf16(bf_lo(v.z) * gb[0] * sc, bf_hi(v.z) * gb[1] * sc);
            o.w = pk_bf16(bf_lo(v.w) * gb[2] * sc, bf_hi(v.w) * gb[3] * sc);
            qf[ks] = __builtin_bit_cast(bf16x8, o);
        }
    }
    unsigned char* ldsK = smem; unsigned char* ldsV = smem + 32768;
    bf16_t* op = Yx + (size_t)(b * SEQ + qpos) * 1024 + head * 256;
    const int krow = tid >> 2, kc0 = (tid & 3) * 8;
    for (int dvh = 0; dvh < 2; ++dvh) {
        f32x16 O[4];
#pragma unroll
        for (int mt = 0; mt < 4; ++mt)
#pragma unroll
            for (int i = 0; i < 16; ++i) O[mt][i] = 0.f;
        float m = -1e30f, l = 0.f;
        for (int c = 0; c < 4; ++c) {
            __syncthreads();
            {
                const bf16_t* kg = Km + (size_t)(c * 64 + krow) * 1024 + kc0 * 8;
#pragma unroll
                for (int j = 0; j < 8; ++j) {
                    const u32x4 v = *(const u32x4*)(kg + j * 8);
                    const int ch = kc0 + j;
                    *(u32x4*)(ldsK + krow * 512 + ((((ch & 15) ^ (krow & 15)) | (ch & 16)) << 4)) = v;
                }
                u32x4 rv[4];
                vt_load<4>(rv, VT + (size_t)(dvh * 128) * 256 + c * 64, 256);
                vt_store<4>(rv, ldsV);
            }
            __syncthreads();
            f32x16 S[2];
#pragma unroll
            for (int kt = 0; kt < 2; ++kt) {
#pragma unroll
                for (int i = 0; i < 16; ++i) S[kt][i] = 0.f;
#pragma unroll
                for (int ks = 0; ks < 16; ++ks) S[kt] = MFMA32(k256_frag(ldsK, kt, ks, lane), qf[ks], S[kt]);
            }
            float mx;
            {
                float m0 = -1e30f, m1 = -1e30f, m2 = -1e30f, m3 = -1e30f;
#pragma unroll
                for (int kt = 0; kt < 2; ++kt)
#pragma unroll
                    for (int i = 0; i < 16; i += 4) { m0 = fmaxf(m0, S[kt][i]); m1 = fmaxf(m1, S[kt][i + 1]); m2 = fmaxf(m2, S[kt][i + 2]); m3 = fmaxf(m3, S[kt][i + 3]); }
                mx = fmaxf(fmaxf(m0, m1), fmaxf(m2, m3));
            }
            mx = fmaxf(mx, __shfl_xor(mx, 32));
            const float mn = fmaxf(m, mx);
            const float alpha = fexp2(m - mn);
            m = mn;
            float ls;
            {
                float l0 = 0.f, l1 = 0.f, l2 = 0.f, l3 = 0.f;
#pragma unroll
                for (int kt = 0; kt < 2; ++kt)
#pragma unroll
                    for (int i = 0; i < 16; i += 4) {
                        const float p0 = fexp2(S[kt][i] - mn), p1 = fexp2(S[kt][i + 1] - mn), p2 = fexp2(S[kt][i + 2] - mn), p3 = fexp2(S[kt][i + 3] - mn);
                        S[kt][i] = p0; S[kt][i + 1] = p1; S[kt][i + 2] = p2; S[kt][i + 3] = p3;
                        l0 += p0; l1 += p1; l2 += p2; l3 += p3;
                    }
                ls = (l0 + l1) + (l2 + l3);
            }
            l = l * alpha + ls;
#pragma unroll
            for (int mt = 0; mt < 4; ++mt)
#pragma unroll
                for (int i = 0; i < 16; ++i) O[mt][i] *= alpha;
#pragma unroll
            for (int kt = 0; kt < 2; ++kt)
#pragma unroll
                for (int s = 0; s < 2; ++s) {
                    const bf16x8 pb = pack8(S[kt], s);
#pragma unroll
                    for (int mt = 0; mt < 4; ++mt) O[mt] = MFMA32(vt_frag(ldsV, mt, kt, s, lane), pb, O[mt]);
                }
        }
        l += __shfl_xor(l, 32);
        const float inv = 1.0f / l;
#pragma unroll
        for (int mt = 0; mt < 4; ++mt)
#pragma unroll
            for (int g = 0; g < 4; ++g) {
                u32x2 wv; wv.x = pk_bf16(O[mt][4 * g] * inv, O[mt][4 * g + 1] * inv); wv.y = pk_bf16(O[mt][4 * g + 2] * inv, O[mt][4 * g + 3] * inv);
                *(u32x2*)(op + dvh * 128 + mt * 32 + 8 * g + 4 * h) = wv;
            }
    }
}

__device__ __forceinline__ void norm_rows(const float* src, const float* gain, bf16_t* dst, float* copy, int nrows) {
    const int lane = get_tid() & 63;
    const int nw = nvb() * 4;
    for (int rr = vbid() * 4 + (get_tid() >> 6); rr < nrows; rr += nw) {
        const f32x4* s = (const f32x4*)(src + (size_t)rr * 1024);
        f32x4 v[4]; float ss = 0.f;
#pragma unroll
        for (int i = 0; i < 4; ++i) { v[i] = s[lane + 64 * i]; ss += v[i][0] * v[i][0] + v[i][1] * v[i][1] + v[i][2] * v[i][2] + v[i][3] * v[i][3]; }
        ss = wave_sum(ss);
        const float rstd = rsqrtf(ss * (1.0f / 1024.0f) + 1e-6f);
#pragma unroll
        for (int i = 0; i < 4; ++i) {
            const f32x4 g = ((const f32x4*)gain)[lane + 64 * i];
            u32x2 o; o.x = pk_bf16(v[i][0] * rstd * g[0], v[i][1] * rstd * g[1]); o.y = pk_bf16(v[i][2] * rstd * g[2], v[i][3] * rstd * g[3]);
            ((u32x2*)(dst + (size_t)rr * 1024))[lane + 64 * i] = o;
            if (copy) ((f32x4*)(copy + (size_t)rr * 1024))[lane + 64 * i] = v[i];
        }
    }
}

__device__ __forceinline__ void wconv_tile(const float* W, bf16_t* Wt, int K, int N, int tile, unsigned char* smem, const float* gk = nullptr) {
    float* lds = (float*)smem;
    const int tid = get_tid();
    const int ntn = N >> 6;
    const int k0 = (tile / ntn) * 64, n0 = (tile % ntn) * 64;
    __syncthreads();
#pragma unroll
    for (int i = 0; i < 4; ++i) {
        const int idx = tid + 256 * i, kr = idx >> 4, c4 = idx & 15;
        f32x4 v = *(const f32x4*)(W + (size_t)(k0 + kr) * N + n0 + c4 * 4);
        if (gk) v = v * gk[k0 + kr];
        lds[kr * 65 + c4 * 4 + 0] = v[0]; lds[kr * 65 + c4 * 4 + 1] = v[1]; lds[kr * 65 + c4 * 4 + 2] = v[2]; lds[kr * 65 + c4 * 4 + 3] = v[3];
    }
    __syncthreads();
#pragma unroll
    for (int i = 0; i < 2; ++i) {
        const int idx = tid + 256 * i, n = idx >> 3, kc = idx & 7;
        u32x4 o;
        o.x = pk_bf16(lds[(kc * 8 + 0) * 65 + n], lds[(kc * 8 + 1) * 65 + n]);
        o.y = pk_bf16(lds[(kc * 8 + 2) * 65 + n], lds[(kc * 8 + 3) * 65 + n]);
        o.z = pk_bf16(lds[(kc * 8 + 4) * 65 + n], lds[(kc * 8 + 5) * 65 + n]);
        o.w = pk_bf16(lds[(kc * 8 + 6) * 65 + n], lds[(kc * 8 + 7) * 65 + n]);
        *(u32x4*)(Wt + (size_t)(n0 + n) * K + k0 + kc * 8) = o;
    }
}

__device__ __forceinline__ void ya_unit(KP p, int e, int unit) {
    const int tid = get_tid(), cgp = tid & 63, w = tid >> 6;
    const bf16_t* P = (const bf16_t*)(p->ws + P_OFF);
    bf16_t* Y = (bf16_t*)(p->ws + Y_OFF);
    const float* cw = p->in[7] + (size_t)e * 3 * 512;
    float w0[8], w1[8], w2[8];
#pragma unroll
    for (int j = 0; j < 8; ++j) { w0[j] = cw[cgp * 8 + j]; w1[j] = cw[512 + cgp * 8 + j]; w2[j] = cw[1024 + cgp * 8 + j]; }
    const int t0 = unit * 32 + w * 8;
    float p1[8], p2[8];
#pragma unroll
    for (int j = 0; j < 8; ++j) { p1[j] = 0.f; p2[j] = 0.f; }
#pragma unroll
    for (int dt = -2; dt < 8; ++dt) {
        const int t = t0 + dt;
        float pr[8];
        const bool inseq = (t >= 0) && ((t & (SEQ - 1)) <= ((t0 + 7) & (SEQ - 1)));
        if (inseq) {
            const u32x4 c = *(const u32x4*)(P + (size_t)t * 2560 + 512 + cgp * 8);
            const u32x4 x = *(const u32x4*)(P + (size_t)t * 2560 + 1024 + cgp * 8);
            pr[0] = bf_lo(c.x) * bf_lo(x.x); pr[1] = bf_hi(c.x) * bf_hi(x.x); pr[2] = bf_lo(c.y) * bf_lo(x.y); pr[3] = bf_hi(c.y) * bf_hi(x.y);
            pr[4] = bf_lo(c.z) * bf_lo(x.z); pr[5] = bf_hi(c.z) * bf_hi(x.z); pr[6] = bf_lo(c.w) * bf_lo(x.w); pr[7] = bf_hi(c.w) * bf_hi(x.w);
        } else {
#pragma unroll
            for (int j = 0; j < 8; ++j) pr[j] = 0.f;
        }
        if (dt >= 0) {
            const u32x4 bb = *(const u32x4*)(P + (size_t)t * 2560 + cgp * 8);
            float o[8];
#pragma unroll
            for (int j = 0; j < 8; ++j) o[j] = w2[j] * pr[j] + w1[j] * p1[j] + w0[j] * p2[j];
            u32x4 ov;
            ov.x = pk_bf16(bf_lo(bb.x) * o[0], bf_hi(bb.x) * o[1]); ov.y = pk_bf16(bf_lo(bb.y) * o[2], bf_hi(bb.y) * o[3]);
            ov.z = pk_bf16(bf_lo(bb.z) * o[4], bf_hi(bb.z) * o[5]); ov.w = pk_bf16(bf_lo(bb.w) * o[6], bf_hi(bb.w) * o[7]);
            *(u32x4*)(Y + (size_t)t * 1024 + cgp * 8) = ov;
        }
#pragma unroll
        for (int j = 0; j < 8; ++j) { p2[j] = p1[j]; p1[j] = pr[j]; }
    }
}

__device__ __forceinline__ void combine_rows(KP p, int layer, int e) {
    const int lane = get_tid() & 63;
    const float lam_init = 0.8f - 0.6f * expf(-0.3f * (float)layer);
    const float* lv = p->in[10] + (size_t)e * 256;
    float a = lv[lane] * lv[64 + lane], bq = lv[128 + lane] * lv[192 + lane];
    a = wave_sum(a); bq = wave_sum(bq);
    const float lam = expf(a) - expf(bq) + lam_init;
    const float* sub = p->in[11] + (size_t)e * 128 + (lane & 15) * 8;
    float sg[8];
#pragma unroll
    for (int j = 0; j < 8; ++j) sg[j] = sub[j] * (1.0f - lam_init);
    const bf16_t* O12 = (const bf16_t*)(p->ws + O12_OFF);
    bf16_t* Y = (bf16_t*)(p->ws + Y_OFF);
    const int nw = nvb() * 4;
    for (int t = vbid() * 4 + (get_tid() >> 6); t < NTOK; t += nw) {
        const u32x4 a1 = *(const u32x4*)(O12 + (size_t)t * 1024 + lane * 8);
        const u32x4 a2 = *(const u32x4*)(O12 + (size_t)t * 1024 + 512 + lane * 8);
        float d[8];
        d[0] = bf_lo(a1.x) - lam * bf_lo(a2.x); d[1] = bf_hi(a1.x) - lam * bf_hi(a2.x);
        d[2] = bf_lo(a1.y) - lam * bf_lo(a2.y); d[3] = bf_hi(a1.y) - lam * bf_hi(a2.y);
        d[4] = bf_lo(a1.z) - lam * bf_lo(a2.z); d[5] = bf_hi(a1.z) - lam * bf_hi(a2.z);
        d[6] = bf_lo(a1.w) - lam * bf_lo(a2.w); d[7] = bf_hi(a1.w) - lam * bf_hi(a2.w);
        float ss = 0.f;
#pragma unroll
        for (int j = 0; j < 8; ++j) ss += d[j] * d[j];
        ss += __shfl_xor(ss, 1); ss += __shfl_xor(ss, 2); ss += __shfl_xor(ss, 4); ss += __shfl_xor(ss, 8);
        const float rstd = rsqrtf(ss * (1.0f / 128.0f) + 1e-6f);
        u32x4 o;
        o.x = pk_bf16(d[0] * rstd * sg[0], d[1] * rstd * sg[1]); o.y = pk_bf16(d[2] * rstd * sg[2], d[3] * rstd * sg[3]);
        o.z = pk_bf16(d[4] * rstd * sg[4], d[5] * rstd * sg[5]); o.w = pk_bf16(d[6] * rstd * sg[6], d[7] * rstd * sg[7]);
        *(u32x4*)(Y + (size_t)t * 1024 + 512 + lane * 8) = o;
    }
}

__device__ __forceinline__ void knorm_rows(KP p, int layer, int first, int nwaves) {
    const int lane = get_tid() & 63;
    bf16_t* Km = (bf16_t*)(p->ws + KM_OFF) + (size_t)layer * 1048576;
    const float* kg = p->in[18] + layer * 256;
    for (int it = first; it < 4096; it += nwaves) {
        bf16_t* row = Km + (size_t)(it >> 2) * 1024 + (it & 3) * 256 + lane * 4;
        const u32x2 v = *(const u32x2*)row;
        float x0 = bf_lo(v.x), x1 = bf_hi(v.x), x2 = bf_lo(v.y), x3 = bf_hi(v.y);
        float ss = wave_sum(x0 * x0 + x1 * x1 + x2 * x2 + x3 * x3);
        const float rstd = rsqrtf(ss * (1.0f / 256.0f) + 1e-6f);
        const f32x4 g = *(const f32x4*)(kg + lane * 4);
        u32x2 o; o.x = pk_bf16(x0 * rstd * g[0], x1 * rstd * g[1]); o.y = pk_bf16(x2 * rstd * g[2], x3 * rstd * g[3]);
        *(u32x2*)row = o;
    }
}

__device__ __forceinline__ void ffn_gate(KP p, int layer) {
    const float* Us = (const float*)(p->ws + US_OFF);
    bf16_t* G = (bf16_t*)(p->ws + G_OFF);
    const float* cw = p->in[21] + (size_t)layer * 3 * 5632;
    const int nitems = 128 * 2 * 704;
    for (int it = vbid() * 256 + get_tid(); it < nitems; it += nvb() * 256) {
        const int cq = it % 704, rr = (it / 704) & 1, gb = it / 1408;
        const int ch = cq * 4;
        const bool hasp = (gb & 31) != 0;
        const f32x4 z = {0.f, 0.f, 0.f, 0.f};
        const float* u0 = Us + (size_t)(gb * 4 + rr) * 5632;
        const float* pl1 = Us + (size_t)((gb - 1) * 4 + 3) * 5632;
        const float* pl2 = Us + (size_t)((gb - 1) * 4 + 2) * 5632;
        const f32x4 g0 = *(const f32x4*)(u0 + ch), v0 = *(const f32x4*)(u0 + 2816 + ch);
        f32x4 g1, g2, v1, v2;
        if (rr == 1) {
            g1 = *(const f32x4*)(Us + (size_t)(gb * 4) * 5632 + ch); v1 = *(const f32x4*)(Us + (size_t)(gb * 4) * 5632 + 2816 + ch);
            g2 = hasp ? *(const f32x4*)(pl1 + ch) : z; v2 = hasp ? *(const f32x4*)(pl1 + 2816 + ch) : z;
        } else {
            g1 = hasp ? *(const f32x4*)(pl1 + ch) : z; v1 = hasp ? *(const f32x4*)(pl1 + 2816 + ch) : z;
            g2 = hasp ? *(const f32x4*)(pl2 + ch) : z; v2 = hasp ? *(const f32x4*)(pl2 + 2816 + ch) : z;
        }
        const f32x4 wg0 = *(const f32x4*)(cw + ch), wg1 = *(const f32x4*)(cw + 5632 + ch), wg2 = *(const f32x4*)(cw + 11264 + ch);
        const f32x4 wv0 = *(const f32x4*)(cw + 2816 + ch), wv1 = *(const f32x4*)(cw + 5632 + 2816 + ch), wv2 = *(const f32x4*)(cw + 11264 + 2816 + ch);
        const f32x4 cg = wg2 * g0 + wg1 * g1 + wg0 * g2;
        const f32x4 cv = wv2 * v0 + wv1 * v1 + wv0 * v2;
        f32x4 o;
#pragma unroll
        for (int e = 0; e < 4; ++e) o[e] = cg[e] * __builtin_amdgcn_rcpf(1.0f + fexp2(-LOG2E * cg[e])) * cv[e];
        u32x2 w; w.x = pk_bf16(o[0], o[1]); w.y = pk_bf16(o[2], o[3]);
        *(u32x2*)(G + (size_t)(gb * 128 + rr) * 2816 + ch) = w;
    }
}

#define XB_TMO      128
#define XB_XCNT(j)  (256  + 64 * (j))
#define XB_XSUB(j)  (1280 + 64 * (j))
#define XB_XGEN(j)  (2304 + 64 * (j))
#define XB_TOP      3328
#define XB_TOPGEN   3392
#define XCD_BAR_WORDS 3456
#define XB_SPIN_CAP (1u << 22)
#define LAS __attribute__((address_space(3)))
__device__ __forceinline__ unsigned xb_ld(unsigned* p)              { return __hip_atomic_load(p, __ATOMIC_RELAXED, __HIP_MEMORY_SCOPE_AGENT); }
__device__ __forceinline__ unsigned xb_add(unsigned* p, unsigned v) { return __hip_atomic_fetch_add(p, v, __ATOMIC_RELAXED, __HIP_MEMORY_SCOPE_AGENT); }
__device__ __forceinline__ unsigned xb_xcc_id() { return (unsigned)__builtin_amdgcn_s_getreg((3 << 11) | 20) & 0xFu; }
#define XB_SPIN(cond, bar) do { unsigned _sp = 0; while (cond) { __builtin_amdgcn_s_sleep(1); \
    if ((++_sp & 255u) == 0u) { if (xb_ld(&(bar)[XB_TMO])) break; if (_sp > XB_SPIN_CAP) { atomicAdd(&(bar)[XB_TMO], 1u); break; } } } } while (0)
struct XcdBarrier { unsigned* bar; unsigned x; volatile LAS unsigned* st; };
__device__ __forceinline__ XcdBarrier xcd_barrier_post(unsigned* bar, volatile LAS unsigned* st) {
    XcdBarrier b; b.bar = bar; b.x = xb_xcc_id(); b.st = st;
    if (threadIdx.x == 0) (void)xb_add(&bar[XB_XCNT(b.x)], 1u);
    return b;
}
__device__ __forceinline__ void xcd_barrier_complete(unsigned* bar, unsigned x, unsigned& nloc, unsigned& nx) {
    const unsigned G = gridDim.x * gridDim.y * gridDim.z;
    unsigned sum, cnt, mine, sp = 0u;
    for (;;) {
        sum = 0u; cnt = 0u; mine = 0u;
#pragma unroll
        for (unsigned j = 0; j < 16; ++j) { const unsigned c = xb_ld(&bar[XB_XCNT(j)]); sum += c; cnt += (c > 0u) ? 1u : 0u; mine = (j == x) ? c : mine; }
        if (sum == G) break;
        __builtin_amdgcn_s_sleep(1);
        if ((++sp & 255u) == 0u) { if (xb_ld(&bar[XB_TMO])) break; if (sp > XB_SPIN_CAP) { atomicAdd(&bar[XB_TMO], 1u); break; } }
    }
    nloc = mine > 0u ? mine : 1u; nx = cnt > 0u ? cnt : 1u;
}
__device__ __forceinline__ void xcd_barrier(const XcdBarrier& b) {
    asm volatile("s_waitcnt vmcnt(0)" ::: "memory");
    __syncthreads();
    if (threadIdx.x == 0) {
        unsigned* bar = b.bar;
        __builtin_amdgcn_s_waitcnt(0);
        unsigned nloc = b.st[0], nx = b.st[1];
        if (nloc == 0u) { xcd_barrier_complete(bar, b.x, nloc, nx); b.st[0] = nloc; b.st[1] = nx; }
        const unsigned old = xb_add(&bar[XB_XSUB(b.x)], 1u);
        const unsigned gen = old / nloc;
        if (old + 1u == (gen + 1u) * nloc) {
            __builtin_amdgcn_fence(__ATOMIC_RELEASE, "agent");
            asm volatile("s_waitcnt vmcnt(0)" ::: "memory");
            const unsigned og = xb_add(&bar[XB_TOP], 1u);
            const unsigned tg = og / nx;
            if (og + 1u == (tg + 1u) * nx) xb_add(&bar[XB_TOPGEN], 1u);
            else XB_SPIN(xb_ld(&bar[XB_TOPGEN]) == tg, bar);
            __builtin_amdgcn_fence(__ATOMIC_ACQUIRE, "agent");
            xb_add(&bar[XB_XGEN(b.x)], 1u);
            asm volatile("s_waitcnt vmcnt(0)" ::: "memory");
        } else {
            XB_SPIN(xb_ld(&bar[XB_XGEN(b.x)]) == gen, bar);
            __builtin_amdgcn_fence(__ATOMIC_ACQUIRE, "agent");
            asm volatile("s_waitcnt vmcnt(0)" ::: "memory");
        }
    }
    __syncthreads();
}

#define NPH 13
struct GemmCnt { int c0, c1, c2, T; };
__device__ __forceinline__ void gemm_desc(KP p, int layer, int ph, int t, const GemmCnt& cn, GemmD& d, int& tm, int& tn) {
    const bool even = (layer & 1) == 0;
    unsigned char* ws = p->ws;
    const bf16_t* H = (const bf16_t*)(ws + H_OFF);
    const bf16_t* MH = (const bf16_t*)(ws + MH_OFF);
    const int c0 = cn.c0, c1 = cn.c1, c2 = cn.c2, T = cn.T;
    const int v = (t & 7) * (T >> 3) + (t >> 3);
        d.mode = 0; d.colblk = 0; d.cbstride = 0; d.g0 = nullptr; d.g1 = nullptr; d.aux = nullptr;
    d.rss = (const float*)(ws + RSS_OFF); d.rsmode = 0; d.nq0 = 0; d.nq1 = 0; d.nsc0 = 0; d.nsplit = 0; d.qscale = 1.f;
        d.lda = 1024; d.ldb = 1024; d.K = 1024;
        int u = v;
        if (ph == 1) {
            if (v < c0) {
                d.A = H; d.B = (const bf16_t*)(ws + WT_IN_OFF); d.MT = 64; d.NT = even ? 10 : 8; d.mode = 2;
                d.rss = (const float*)(ws + RSS_OFF) + (size_t)(3 * layer) * RSS_SLOT; d.rsmode = 1;
                d.C = ws + P_OFF; d.ldc = even ? 2560 : 2048;
                if (even) { const int e = layer >> 1; d.nq0 = 1536; d.nq1 = 2560; d.nsc0 = 1536; d.nsplit = 2048; d.g0 = p->in[8] + e * 64; d.g1 = p->in[9] + e * 64; d.qscale = 0.125f * LOG2E; }
                else { d.nq0 = 0; d.nq1 = 0; d.nsc0 = 0; d.nsplit = 1024; d.qscale = 0.125f; }
            } else if (v < c0 + c1) {
                u = v - c0;
                const int nv = even ? 512 : 1024;
                d.A = (const bf16_t*)(ws + WT_IN_OFF) + (size_t)(even ? 2560 : 2048) * 1024; d.B = H; d.MT = nv / 256; d.NT = 64;
                d.rss = (const float*)(ws + RSS_OFF) + (size_t)(3 * layer) * RSS_SLOT; d.rsmode = 2;
                d.C = ws + VT_OFF; d.ldc = SEQ; d.colblk = SEQ; d.cbstride = (long)nv * SEQ;
            } else if (v < c0 + c1 + c2) {
                u = v - c0 - c1;
                const int lm = u >> 4; u &= 15;
                d.A = MH + (size_t)lm * 1048576; d.B = (const bf16_t*)(ws + WTKV4_OFF) + (size_t)lm * 2097152; d.MT = 4; d.NT = 4;
                d.C = ws + KM_OFF + (size_t)lm * 2097152; d.ldc = 1024;
            } else {
                u = v - c0 - c1 - c2;
                const int lm = u >> 4; u &= 15;
                d.A = (const bf16_t*)(ws + WTKV4_OFF) + (size_t)lm * 2097152 + (size_t)1024 * 1024; d.B = MH + (size_t)lm * 1048576; d.MT = 4; d.NT = 4;
                d.C = ws + VTM_OFF + (size_t)lm * 2097152; d.ldc = 256; d.colblk = 256; d.cbstride = 1024L * 256;
            }
        } else if (ph == 4) {
            d.A = (const bf16_t*)(ws + Y_OFF); d.B = (const bf16_t*)(ws + WT_OUT_OFF); d.MT = 64; d.NT = 4; d.mode = 1; d.C = p->X; d.ldc = 1024;
            d.aux = (float*)(ws + RSS_OFF) + (size_t)(3 * layer + 1) * RSS_SLOT; d.g1 = (const float*)(ws + H_OFF);
        } else if (ph == 6) {
            d.A = H; d.B = (const bf16_t*)(ws + WT_XQ_OFF); d.MT = 64; d.NT = 4; d.C = ws + QX_OFF; d.ldc = 1024;
            d.rss = (const float*)(ws + RSS_OFF) + (size_t)(3 * layer + 1) * RSS_SLOT; d.rsmode = 1;
        } else if (ph == 8) {
            d.A = (const bf16_t*)(ws + YX_OFF); d.B = (const bf16_t*)(ws + WT_XO_OFF); d.MT = 64; d.NT = 4; d.mode = 1; d.C = p->X; d.ldc = 1024;
            d.aux = (float*)(ws + RSS_OFF) + (size_t)(3 * layer + 2) * RSS_SLOT; d.g1 = (const float*)(ws + H_OFF);
        } else if (ph == 10) {
            d.A = H; d.B = (const bf16_t*)(ws + WT_UP_OFF); d.MT = 64; d.NT = 22; d.mode = 4; d.C = ws + G_OFF; d.ldc = 2816; d.rss = (const float*)(ws + RSS_OFF) + (size_t)(3 * layer + 2) * RSS_SLOT; d.rsmode = 1; d.g0 = p->in[21] + (size_t)layer * 3 * 5632; d.aux = (float*)(ws + US_OFF);
        } else {
            d.A = (const bf16_t*)(ws + G_OFF); d.B = (const bf16_t*)(ws + WT_DOWN_OFF); d.lda = 2816; d.ldb = 2816; d.K = 2816;
            d.MT = 64; d.NT = 4; d.mode = 1; d.C = p->X; d.ldc = 1024;
            d.aux = (float*)(ws + RSS_OFF) + (size_t)(3 * layer + 3) * RSS_SLOT; d.g1 = (const float*)(ws + H_OFF);
        }
        tile_map(u, d.MT, d.NT, tm, tn);
}

#define GEMM_RSRC(P) __builtin_amdgcn_make_buffer_rsrc((void*)(P), 0, 0x7fffffff, 0x00020000)
typedef __attribute__((address_space(3))) void* lds_ptr_t;
#define GEMM_DMA1(PA, PB, BROWB, BUF, KOFS, i_) do { \
        const int soa_ = (KOFS) + (wid * 32 + (i_) * 8) * ld * 2; \
        const int sob_ = (KOFS) + (BROWB) + (i_) * 8 * ld * 2; \
        __builtin_amdgcn_raw_ptr_buffer_load_lds((PA), (lds_ptr_t)((BUF) + (wid * 4 + (i_)) * 1024), 16, ((i_) & 1) ? vodd : veven, soa_, 0, 0); \
        __builtin_amdgcn_raw_ptr_buffer_load_lds((PB), (lds_ptr_t)((BUF) + 32768 + (wid * 4 + (i_)) * 1024), 16, ((i_) & 1) ? vodd : veven, sob_, 0, 0); } while (0)
#define GEMM_DMA(PA, PB, BROWB, BUF, KOFS) do { _Pragma("unroll") for (int i_ = 0; i_ < 4; ++i_) GEMM_DMA1(PA, PB, BROWB, BUF, KOFS, i_); } while (0)
#define GEMM_STEP(BUF, DO_DMA, PA, PB, BROWB, NBUF, KOFS) do { _Pragma("unroll") for (int ks_ = 0; ks_ < 2; ++ks_) { bf16x8 af_[8], bf_[4]; \
        _Pragma("unroll") for (int ni_ = 0; ni_ < 4; ++ni_) bf_[ni_] = *(const bf16x8*)((BUF) + (ks_ ? bofs1 : bofs0) + ni_ * 2048); \
        _Pragma("unroll") for (int mi_ = 0; mi_ < 8; ++mi_) af_[mi_] = *(const bf16x8*)((BUF) + (ks_ ? aofs1 : aofs0) + mi_ * 2048); \
        if (DO_DMA) { GEMM_DMA1(PA, PB, BROWB, NBUF, KOFS, ks_ * 2); GEMM_DMA1(PA, PB, BROWB, NBUF, KOFS, ks_ * 2 + 1); } \
        __builtin_amdgcn_s_setprio(1); \
        _Pragma("unroll") for (int mi_ = 0; mi_ < 8; ++mi_) _Pragma("unroll") for (int ni_ = 0; ni_ < 4; ++ni_) \
            acc[mi_][ni_] = __builtin_amdgcn_mfma_f32_16x16x32_bf16(bf_[ni_], af_[mi_], acc[mi_][ni_], 0, 0, 0); \
        __builtin_amdgcn_s_setprio(0); \
        } } while (0)

__device__ __forceinline__ void run_gemm_list(KP p, int layer, int ph, unsigned char* smem) {
    const bool even = (layer & 1) == 0;
    GemmCnt cn; cn.c0 = 0; cn.c1 = 0; cn.c2 = 0;
    int c3 = 0;
    if (ph == 1) { cn.c0 = even ? 64 * 10 : 64 * 8; cn.c1 = even ? 2 * 64 : 4 * 64; cn.c2 = (layer == 0) ? 64 : 0; c3 = cn.c2; }
    else if (ph == 10) { cn.c0 = 64 * 22; }
    else { cn.c0 = 64 * 4; }
    cn.T = cn.c0 + cn.c1 + cn.c2 + c3;
    int t = blockIdx.x;
    if (t >= cn.T) return;
    const int ld = (ph == 12) ? 2816 : 1024;
    const int nk = ld >> 6;
    const int tid = get_tid512(), lane = tid & 63, wid = __builtin_amdgcn_readfirstlane(tid >> 6), wr = wid >> 2, wc = wid & 3;
    const int fr = lane & 15, fq = lane >> 4;
    const int dr = lane >> 3, dp = lane & 7;
    const unsigned veven = (unsigned)(dr * ld * 2 + ((dp ^ (dr >> 1)) << 4));
    const unsigned vodd  = (unsigned)(dr * ld * 2 + ((dp ^ (4 + (dr >> 1))) << 4));
    const int swz = (fr >> 1) & 7;
    const int aofs0 = (wr * 128 + fr) * 128 + (((0 + fq) ^ swz) << 4);
    const int aofs1 = (wr * 128 + fr) * 128 + (((4 + fq) ^ swz) << 4);
    const int bofs0 = 32768 + (wc * 64 + fr) * 128 + (((0 + fq) ^ swz) << 4);
    const int bofs1 = 32768 + (wc * 64 + fr) * 128 + (((4 + fq) ^ swz) << 4);
    unsigned char* buf0 = smem; unsigned char* buf1 = smem + 65536;

    GemmD d; int tm, tn;
    gemm_desc(p, layer, ph, t, cn, d, tm, tn);
    __amdgpu_buffer_rsrc_t Ag = GEMM_RSRC((const char*)d.A + (size_t)tm * 512 * ld);
    const bool gate = (ph == 10);
#define GEMM_BROW(TN) (gate ? (((wid & 1) ? 2816 : 0) + (TN) * 128 + (wid >> 1) * 32) * ld * 2 : wid * 32 * ld * 2)
    __amdgpu_buffer_rsrc_t Bg = GEMM_RSRC((const char*)d.B + (gate ? (size_t)0 : (size_t)tn * 512 * ld));
    int browb = GEMM_BROW(tn);
    __syncthreads();
    GEMM_DMA(Ag, Bg, browb, buf0, 0);
    __syncthreads();
    for (;;) {
        const int t2 = t + gridDim.x;
        const bool hasn = t2 < cn.T;
        __amdgpu_buffer_rsrc_t nAg = Ag, nBg = Bg; int nbrowb = browb;
        if (hasn) {
            GemmD dn; int ntm, ntn;
            gemm_desc(p, layer, ph, t2, cn, dn, ntm, ntn);
            nAg = GEMM_RSRC((const char*)dn.A + (size_t)ntm * 512 * ld);
            nBg = GEMM_RSRC((const char*)dn.B + (gate ? (size_t)0 : (size_t)ntn * 512 * ld));
            nbrowb = GEMM_BROW(ntn);
        }
        f32x4 acc[8][4];
#pragma unroll
        for (int i = 0; i < 8; ++i)
#pragma unroll
            for (int j = 0; j < 4; ++j) acc[i][j] = (f32x4){0.f, 0.f, 0.f, 0.f};
        for (int kt = 0; kt < nk; kt += 2) {
            const bool last = (kt + 2 >= nk);
            GEMM_STEP(buf0, 1, Ag, Bg, browb, buf1, (kt + 1) * 128);
            __syncthreads();
            {
                const bool dodma = !last || hasn;
                const __amdgpu_buffer_rsrc_t sA = last ? nAg : Ag, sB = last ? nBg : Bg;
                const int kofs = last ? 0 : (kt + 2) * 128;
                const int sbrow = last ? nbrowb : browb;
                GEMM_STEP(buf1, dodma, sA, sB, sbrow, buf0, kofs);
            }
            __syncthreads();
        }
        {
            int tl = t; asm volatile("" : "+s"(tl));
            gemm_desc(p, layer, ph, tl, cn, d, tm, tn);
        }
        __shared__ float rstab[256];
        if (d.rsmode) {
            const int tq = get_tid512();
            if (tq < 256) rstab[tq] = rss_rstd(d.rss + (size_t)(((d.rsmode == 1) ? tm : tn) * 256 + tq) * 16);
            __syncthreads();
        }
        gemm_epilogue(d, tm, tn, acc, rstab);
        if (!hasn) break;
        t = t2; Ag = nAg; Bg = nBg; browb = nbrowb;
        gemm_desc(p, layer, ph, t, cn, d, tm, tn);
    }
}

__device__ __forceinline__ void run_phase(KP p, int layer, int ph, unsigned char* smem_all) {
    const bool even = (layer & 1) == 0;
    unsigned char* ws = p->ws;
    unsigned char* smem = smem_all + vhalf() * 65536;
    switch (ph) {
    case 0: {
        const int e = layer >> 1;
        const int n_in = 16 * 48, n_out = 16 * 16, n_xq = 256, n_xkv = (layer == 0) ? 4 * 16 * 32 : 0, n_xo = 256, n_up = 16 * 88, n_dn = 44 * 16;
        const int T = n_in + n_out + n_xq + n_xkv + n_xo + n_up + n_dn;
        for (int t = vbid(); t < T; t += nvb()) {
            int u = t;
            if (u < n_in) { wconv_tile(even ? p->in[6] + (size_t)e * 1024 * 3072 : p->in[13] + (size_t)e * 1024 * 3072, (bf16_t*)(ws + WT_IN_OFF), 1024, 3072, u, smem, p->in[2] + layer * 1024); continue; }
            u -= n_in;
            if (u < n_out) { wconv_tile(even ? p->in[12] + (size_t)e * 1024 * 1024 : p->in[14] + (size_t)e * 1024 * 1024, (bf16_t*)(ws + WT_OUT_OFF), 1024, 1024, u, smem); continue; }
            u -= n_out;
            if (u < n_xq) { wconv_tile(p->in[15] + (size_t)layer * 1024 * 1024, (bf16_t*)(ws + WT_XQ_OFF), 1024, 1024, u, smem, p->in[3] + layer * 1024); continue; }
            u -= n_xq;
            if (u < n_xkv) { const int lm = u >> 9; wconv_tile(p->in[16] + (size_t)lm * 1024 * 2048, (bf16_t*)(ws + WTKV4_OFF) + (size_t)lm * 2097152, 1024, 2048, u & 511, smem); continue; }
            u -= n_xkv;
            if (u < n_xo) { wconv_tile(p->in[19] + (size_t)layer * 1024 * 1024, (bf16_t*)(ws + WT_XO_OFF), 1024, 1024, u, smem); continue; }
            u -= n_xo;
            if (u < n_up) { wconv_tile(p->in[20] + (size_t)layer * 1024 * 5632, (bf16_t*)(ws + WT_UP_OFF), 1024, 5632, u, smem, p->in[20 - 15] + layer * 1024); continue; }
            u -= n_up;
            wconv_tile(p->in[22] + (size_t)layer * 2816 * 1024, (bf16_t*)(ws + WT_DOWN_OFF), 2816, 1024, u, smem);
        }
        if (layer == 0) {
            const int lane = get_tid() & 63;
            float* rs0 = (float*)(ws + RSS_OFF);
            for (int rr = vbid() * 4 + (get_tid() >> 6); rr < NTOK; rr += nvb() * 4) {
                const f32x4* sp = (const f32x4*)(p->in[0] + (size_t)rr * 1024);
                float ss = 0.f;
#pragma unroll
                for (int i = 0; i < 4; ++i) {
                    const f32x4 v = sp[lane + 64 * i];
                    ss += v[0] * v[0] + v[1] * v[1] + v[2] * v[2] + v[3] * v[3];
                    ((f32x4*)(p->X + (size_t)rr * 1024))[lane + 64 * i] = v;
                    u32x2 o; o.x = pk_bf16(v[0], v[1]); o.y = pk_bf16(v[2], v[3]);
                    ((u32x2*)((bf16_t*)(ws + H_OFF) + (size_t)rr * 1024))[lane + 64 * i] = o;
                }
                ss = wave_sum(ss);
                if (lane < 16) rs0[(size_t)rr * 16 + lane] = (lane == 0) ? ss : 0.f;
            }
        }
        if (layer == 0) for (int lm = 0; lm < 4; ++lm) norm_rows(p->in[1], p->in[4] + lm * 1024, (bf16_t*)(ws + MH_OFF) + (size_t)lm * 1048576, nullptr, 1024);
    } break;
    case 1: case 4: case 6: case 8: case 10: case 12:
        run_gemm_list(p, layer, ph, smem_all); break;
    case 2: {
        if (even) {
            const int e2 = layer >> 1;
            float smax2;
            {
                const int ln = get_tid() & 63;
                float ga = fabsf(p->in[8][e2 * 64 + ln]), gb = fabsf(p->in[9][e2 * 64 + ln]);
#pragma unroll
                for (int o = 32; o >= 1; o >>= 1) { ga = fmaxf(ga, __shfl_xor(ga, o)); gb = fmaxf(gb, __shfl_xor(gb, o)); }
                smax2 = 0.125f * LOG2E * 64.0f * ga * gb;
            }
            const float lam_init = 0.8f - 0.6f * expf(-0.3f * (float)layer);
            float lam;
            {
                const int ln = get_tid() & 63;
                const float* lv = p->in[10] + (size_t)e2 * 256;
                float a = lv[ln] * lv[64 + ln], bq = lv[128 + ln] * lv[192 + ln];
                a = wave_sum(a); bq = wave_sum(bq);
                lam = expf(a) - expf(bq) + lam_init;
            }
            unsigned* ctr = (unsigned*)(ws + BAR_OFF) + 3600 + e2;
            __shared__ int s_unit;
            for (;;) {
                __syncthreads();
                if (threadIdx.x == 0) s_unit = (int)__hip_atomic_fetch_add(ctr, 1u, __ATOMIC_RELAXED, __HIP_MEMORY_SCOPE_AGENT);
                __syncthreads();
                const int u = s_unit;
                if (u >= 512) break;
                const int qi = 31 - (u >> 4), b = (u >> 2) & 3, head = u & 3, br = vhalf();
                const float slope2 = exp2f(-2.0f * (float)(head + 1)) * LOG2E;
                const float Df = (151.0f + 2.0f * smax2) / slope2;
                int cmin = 0;
                if (Df < 8192.0f) { const int a = qi * 128 - 63 - ((int)Df + 1); cmin = a > 0 ? (a + 63) >> 6 : 0; }
                diff_attn_unit(p, b, head, br, qi, cmin, smem, smem_all + 65536, lam, p->in[11] + (size_t)e2 * 128, 1.0f - lam_init);
            }
            for (int u = vbid(); u < 512; u += nvb()) ya_unit(p, layer >> 1, u);
        } else {
            for (int j = blockIdx.x; j < 1024; j += gridDim.x) {
                const int bhp = j >> 5, i = j & 31;
                sb_attn_unit(p, bhp >> 3, (bhp & 7) * 2 + vhalf(), 31 - i, smem, (volatile int*)(smem_all + 32768));
            }
        }
        knorm_rows(p, layer, vbid() * 4 + (get_tid() >> 6), nvb() * 4);
    } break;
    case 3: if (even) combine_rows(p, layer, layer >> 1); break;
    case 7: {
        for (int j = vbid(); j < 512; j += nvb()) {
            const int bh = j >> 5, i = j & 31;
            cross_attn_unit(p, layer, bh >> 2, bh & 3, i, smem);
        }
    } break;
    case 11: ffn_gate(p, layer); break;
    }
}

__global__ void __launch_bounds__(512, 2) mega(Params p_arg, int ph_begin, int ph_end, int coop) {
    __shared__ __attribute__((aligned(16))) unsigned char smem[131072];
    __shared__ uint4 xb_words;
    cg::grid_group grid = cg::this_grid();
    KP p = (KP)__builtin_amdgcn_kernarg_segment_ptr();
    if (p->ws == nullptr) grid.sync();
    XcdBarrier xb;
    if (coop) {
        if (threadIdx.x == 0) xb_words = make_uint4(0u, 0u, 0u, 0u);
        __syncthreads();
        xb = xcd_barrier_post((unsigned*)(p->ws + BAR_OFF), (volatile LAS unsigned*)&xb_words);
    }
    for (int gp = ph_begin; gp < ph_end; ++gp) {
        const int layer = gp / NPH, ph = gp % NPH;
        if (ph == 3) continue;
        if (ph == 5 || ph == 9) continue;
        asm volatile("" : "+s"(p));
        run_phase(p, layer, ph, smem);
        if (coop && gp + 1 < ph_end) xcd_barrier(xb);
    }
}

__global__ void dbg_sanitize(float* X, int n) {
    for (int i = blockIdx.x * 256 + threadIdx.x; i < n; i += gridDim.x * 256) { float v = X[i]; if (!(fabsf(v) < 1e30f)) X[i] = 12345.0f; }
}
extern "C" void kernel_launch(void* const* d_in, const int* in_sizes, int n_in, void* d_out, int out_size, void* d_ws, size_t ws_size,
                              hipStream_t stream) {
    static int grid_blocks = 0;
    if (!grid_blocks) {
        int dev = 0, cus = 0, per_cu = 0;
        hipGetDevice(&dev);
        hipDeviceGetAttribute(&cus, hipDeviceAttributeMultiprocessorCount, dev);
        hipOccupancyMaxActiveBlocksPerMultiprocessor(&per_cu, mega, 512, 0);
        if (per_cu > 1) per_cu = 1;
        if (per_cu < 1) per_cu = 1;
        grid_blocks = cus * per_cu;
    }
    if (ws_size < (size_t)WS_NEED) return;
    Params p{};
    for (int i = 0; i < 23; ++i) p.in[i] = (const float*)d_in[i];
    p.X = (float*)d_out;
    p.ws = (unsigned char*)d_ws;
#ifndef MULTI_LAUNCH
#define MULTI_LAUNCH 0
#endif
#ifndef DBG_END
#define DBG_END 52
#endif
#if MULTI_LAUNCH
    for (int g = 0; g < DBG_END; ++g) {
        if ((g % NPH) == 3) continue;
        if ((g % NPH) == 5 || (g % NPH) == 9) continue;
        hipLaunchKernelGGL(mega, dim3(grid_blocks), dim3(512), 0, stream, p, g, g + 1, 0);
    }
#else
    hipMemsetAsync((unsigned char*)d_ws + BAR_OFF, 0, 16384, stream);
    int b = 0, e = 4 * NPH, coop = 1;
    void* args[] = {&p, &b, &e, &coop};
    hipError_t err = hipLaunchCooperativeKernel((void*)mega, dim3(grid_blocks), dim3(512), args, 0, stream);
    if (err != hipSuccess) fprintf(stderr, "cooperative launch failed: %s (grid %d)\n", hipGetErrorString(err), grid_blocks);
#endif
}
```
